# Optimizing an MI355X kernel written in HIP

```python
import jax, jax.numpy as jnp
from jax import lax
import numpy as np

D_MODEL = 1024
BATCH = 4
SEQ = 8192
DEPTH = 2

HEAD_DIM = 64
GLA_HEADS = 4
GDN_HEADS = 4
MOBA_HEADS = 8
GLA_W = GLA_HEADS * HEAD_DIM
GDN_W = GDN_HEADS * HEAD_DIM
MOBA_W = MOBA_HEADS * HEAD_DIM
D_MIX = GLA_W + GDN_W + MOBA_W
GLA_GATE_RANK = 16
GLA_GATE_TAU = 16.0
CHUNK = 64
CONV_WIDTH = 4
MOBA_BLOCK = 256
MOBA_TOPK = 3
MOBA_QCHUNK = 32
ROPE_THETA = 10000.0
D_FF = -(-(8 * D_MODEL) // (3 * 256)) * 256
RMS_EPS = 1e-6
IN_SPLITS = (GLA_W, GLA_W, GLA_W, GLA_W, GLA_GATE_RANK,
             GDN_W, GDN_W, GDN_W, GDN_W, GDN_HEADS, GDN_HEADS,
             MOBA_W, MOBA_W, MOBA_W)
N_IN = sum(IN_SPLITS)

kernel_name = "hybrid_gla_gdn_moba_parallel_heads"

F32 = jnp.float32


def rms_norm(x, w):
    xf = x.astype(F32)
    y = xf * lax.rsqrt(jnp.mean(xf * xf, axis=-1, keepdims=True) + RMS_EPS)
    return (y * w.astype(F32)).astype(x.dtype)


def l2_norm(t):
    return t * lax.rsqrt(jnp.sum(t * t, axis=-1, keepdims=True) + RMS_EPS)


def rope(t, pos):
    half = HEAD_DIM // 2
    inv = ROPE_THETA ** (-jnp.arange(half, dtype=F32) / half)
    ang = pos.astype(F32)[:, None] * inv[None, :]
    cos = jnp.cos(ang)[:, None, :]
    sin = jnp.sin(ang)[:, None, :]
    tf = t.astype(F32)
    t1, t2 = tf[..., :half], tf[..., half:]
    return jnp.concatenate([t1 * cos - t2 * sin, t2 * cos + t1 * sin], -1).astype(t.dtype)


def causal_depthwise_conv(x, w):
    c = x.shape[-1]
    return lax.conv_general_dilated(
        x, w.astype(x.dtype)[:, None, :], window_strides=(1,),
        padding=[(CONV_WIDTH - 1, 0)], dimension_numbers=("NWC", "WIO", "NWC"),
        feature_group_count=c)


def gla_chunked(q, k, v, log_a):
    b_, h_, s_, dk = q.shape
    dv = v.shape[-1]
    n = s_ // CHUNK
    to_chunks = lambda t: jnp.moveaxis(t.reshape(b_, h_, n, CHUNK, t.shape[-1]), 2, 0)
    incl = jnp.tril(jnp.ones((CHUNK, CHUNK), bool))

    def step(state, inp):
        qc, kc, vc, gc = inp
        cum = jnp.cumsum(gc, axis=-2)
        o_inter = jnp.einsum('bhcd,bhde->bhce', qc * jnp.exp(cum), state)
        diff = cum[:, :, :, None, :] - cum[:, :, None, :, :]
        decay = jnp.exp(jnp.where(incl[:, :, None], diff, -jnp.inf))
        attn = jnp.einsum('bhid,bhjd,bhijd->bhij', qc, kc, decay)
        o = o_inter + jnp.einsum('bhij,bhje->bhie', attn, vc)
        last = cum[:, :, -1:, :]
        state = jnp.exp(last[:, :, 0, :])[..., None] * state + jnp.einsum(
            'bhcd,bhce->bhde', kc * jnp.exp(last - cum), vc)
        return state, o

    s0 = jnp.zeros((b_, h_, dk, dv), F32)
    _, o = lax.scan(step, s0, (to_chunks(q), to_chunks(k), to_chunks(v), to_chunks(log_a)))
    return jnp.moveaxis(o, 0, 2).reshape(b_, h_, s_, dv)


def gdn_chunked(q, k, v, g, beta):
    b_, h_, s_, dk = q.shape
    dv = v.shape[-1]
    n = s_ // CHUNK
    c = lambda t: t.reshape((b_, h_, n, CHUNK) + t.shape[3:])
    q, k, v, g, beta = c(q), c(k), c(v), c(g), c(beta)
    g = jnp.cumsum(g, axis=-1)
    incl = jnp.tril(jnp.ones((CHUNK, CHUNK), bool))
    strict = jnp.tril(jnp.ones((CHUNK, CHUNK), bool), -1)
    decay = jnp.exp(jnp.where(incl, g[..., :, None] - g[..., None, :], -jnp.inf))
    k_beta = k * beta[..., None]
    v_beta = v * beta[..., None]
    lower = jnp.where(strict, jnp.einsum('bhnid,bhnjd->bhnij', k_beta, k) * decay, 0.0)
    eye = jnp.eye(CHUNK, dtype=F32)
    rhs = jnp.concatenate([v_beta, k_beta * jnp.exp(g)[..., None]], axis=-1)
    sol = lax.linalg.triangular_solve(eye + lower, rhs, left_side=True, lower=True,
                                      unit_diagonal=True)
    u, w = sol[..., :dv], sol[..., dv:]
    attn = jnp.where(incl, jnp.einsum('bhnid,bhnjd->bhnij', q, k) * decay, 0.0)

    def step(state, inp):
        qi, ki, ui, wi, ai, gi = inp
        v_new = ui - jnp.einsum('bhck,bhkv->bhcv', wi, state)
        o = jnp.einsum('bhck,bhkv->bhcv', qi * jnp.exp(gi)[..., None], state) + \
            jnp.einsum('bhij,bhjv->bhiv', ai, v_new)
        g_last = gi[..., -1:]
        state = state * jnp.exp(g_last)[..., None] + jnp.einsum(
            'bhck,bhcv->bhkv', ki * jnp.exp(g_last - gi)[..., None], v_new)
        return state, o

    xs = tuple(jnp.moveaxis(t, 2, 0) for t in (q, k, u, w, attn, g))
    _, o = lax.scan(step, jnp.zeros((b_, h_, dk, dv), F32), xs)
    return jnp.moveaxis(o, 0, 2).reshape(b_, h_, s_, dv)


def gla_mixer(q, k, v, z, a_low, w_gate, b_gate, norm_w):
    b_, s_, _ = q.shape
    heads = lambda t: t.astype(F32).reshape(b_, s_, GLA_HEADS, HEAD_DIM).transpose(0, 2, 1, 3)
    log_a = jax.nn.log_sigmoid((a_low @ w_gate + b_gate).astype(F32)) / GLA_GATE_TAU
    o = gla_chunked(heads(q) * HEAD_DIM ** -0.5, heads(k), heads(v), heads(log_a))
    o = rms_norm(o.transpose(0, 2, 1, 3), norm_w).reshape(b_, s_, GLA_W)
    return (o * jax.nn.silu(z.astype(F32))).astype(q.dtype)


def gdn_mixer(q, k, v, z, b_raw, a_raw, conv_w, a_log, dt_bias, norm_w):
    b_, s_, _ = q.shape
    qkv = jax.nn.silu(causal_depthwise_conv(jnp.concatenate([q, k, v], -1), conv_w))
    q, k, v = jnp.split(qkv.astype(F32), 3, axis=-1)
    heads = lambda t: t.reshape(b_, s_, GDN_HEADS, HEAD_DIM).transpose(0, 2, 1, 3)
    q = l2_norm(heads(q)) * HEAD_DIM ** -0.5
    k = l2_norm(heads(k))
    beta = jax.nn.sigmoid(b_raw.astype(F32)).transpose(0, 2, 1)
    g = (-jnp.exp(a_log.astype(F32)) *
         jax.nn.softplus(a_raw.astype(F32) + dt_bias.astype(F32))).transpose(0, 2, 1)
    o = gdn_chunked(q, k, heads(v), g, beta)
    o = rms_norm(o.transpose(0, 2, 1, 3), norm_w).reshape(b_, s_, GDN_W)
    return (o * jax.nn.silu(z.astype(F32))).astype(z.dtype)


def moba_mixer(q, k, v):
    b_, s_, _ = q.shape
    pos = jnp.arange(s_)
    heads = lambda t: t.reshape(b_, s_, MOBA_HEADS, HEAD_DIM)
    q = rope(heads(q), pos).transpose(0, 2, 1, 3)
    k = rope(heads(k), pos).transpose(0, 2, 1, 3)
    v = heads(v).transpose(0, 2, 1, 3)
    sp = -(-s_ // MOBA_BLOCK) * MOBA_BLOCK
    padw = ((0, 0), (0, 0), (0, sp - s_), (0, 0))
    q, k, v = jnp.pad(q, padw), jnp.pad(k, padw), jnp.pad(v, padw)
    nb = sp // MOBA_BLOCK
    nq = sp // MOBA_QCHUNK
    topk = min(MOBA_TOPK, nb)
    kb = k.reshape(b_, MOBA_HEADS, nb, MOBA_BLOCK, HEAD_DIM)
    vb = v.reshape(b_, MOBA_HEADS, nb, MOBA_BLOCK, HEAD_DIM)
    k_mean = jnp.mean(kb.astype(F32), axis=-2)
    qch = jnp.moveaxis(q.reshape(b_, MOBA_HEADS, nq, MOBA_QCHUNK, HEAD_DIM), 2, 0)
    bi = jnp.arange(b_)[:, None, None, None]
    hi = jnp.arange(MOBA_HEADS)[None, :, None, None]
    scale = HEAD_DIM ** -0.5

    def one_chunk(args):
        qc, ci = args
        q_pos = ci * MOBA_QCHUNK + jnp.arange(MOBA_QCHUNK)
        own = (ci * MOBA_QCHUNK) // MOBA_BLOCK
        gate = jnp.einsum('bhqd,bhnd->bhqn', qc.astype(F32), k_mean)
        gate = jnp.where(jnp.arange(nb) < own, gate, -jnp.inf)
        _, idx = lax.top_k(gate, topk)
        valid = idx < own
        k_sel = kb[bi, hi, idx]
        v_sel = vb[bi, hi, idx]
        s_sel = jnp.einsum('bhqd,bhqnkd->bhqnk', qc, k_sel).astype(F32) * scale
        s_sel = jnp.where(valid[..., None], s_sel, -jnp.inf).reshape(
            b_, MOBA_HEADS, MOBA_QCHUNK, topk * MOBA_BLOCK)
        k_own = lax.dynamic_index_in_dim(kb, own, axis=2, keepdims=False)
        v_own = lax.dynamic_index_in_dim(vb, own, axis=2, keepdims=False)
        s_own = jnp.einsum('bhqd,bhkd->bhqk', qc, k_own).astype(F32) * scale
        key_pos = own * MOBA_BLOCK + jnp.arange(MOBA_BLOCK)
        s_own = jnp.where(key_pos[None, :] <= q_pos[:, None], s_own, -jnp.inf)
        p = jax.nn.softmax(jnp.concatenate([s_sel, s_own], axis=-1), axis=-1)
        p_sel = p[..., :topk * MOBA_BLOCK].reshape(
            b_, MOBA_HEADS, MOBA_QCHUNK, topk, MOBA_BLOCK).astype(v.dtype)
        p_own = p[..., topk * MOBA_BLOCK:].astype(v.dtype)
        return (jnp.einsum('bhqnk,bhqnkd->bhqd', p_sel, v_sel) +
                jnp.einsum('bhqk,bhkd->bhqd', p_own, v_own))

    o = lax.map(one_chunk, (qch, jnp.arange(nq)))
    o = jnp.moveaxis(o, 0, 2).reshape(b_, MOBA_HEADS, sp, HEAD_DIM)[:, :, :s_]
    return o.transpose(0, 2, 1, 3).reshape(b_, s_, MOBA_W)


def setup_inputs(seed: int = 0) -> dict:
    key = jax.random.key(seed)
    ks = jax.random.split(key, 18)
    nrm = lambda kk, shape: jax.random.normal(kk, shape, F32)
    gain = lambda kk, shape: 1.0 + 0.05 * nrm(kk, shape)
    dt = jnp.exp(jax.random.uniform(ks[12], (DEPTH, GDN_HEADS), F32,
                                    np.log(1e-3), np.log(1e-1)))
    return {
        "x": nrm(ks[0], (BATCH, SEQ, D_MODEL)),
        "norm_mix_pre": gain(ks[1], (DEPTH, D_MODEL)),
        "norm_mix_post": gain(ks[2], (DEPTH, D_MODEL)),
        "norm_ffn_pre": gain(ks[3], (DEPTH, D_MODEL)),
        "norm_ffn_post": gain(ks[4], (DEPTH, D_MODEL)),
        "w_in": nrm(ks[5], (DEPTH, D_MODEL, N_IN)) * D_MODEL ** -0.5,
        "w_o": nrm(ks[6], (DEPTH, D_MIX, D_MODEL)) * D_MIX ** -0.5,
        "gla_w_gate": nrm(ks[7], (DEPTH, GLA_GATE_RANK, GLA_W)) * GLA_GATE_RANK ** -0.5,
        "gla_b_gate": 0.1 * nrm(ks[8], (DEPTH, GLA_W)),
        "gla_norm": gain(ks[9], (DEPTH, HEAD_DIM)),
        "gdn_conv": nrm(ks[10], (DEPTH, CONV_WIDTH, 3 * GDN_W)) * CONV_WIDTH ** -0.5,
        "gdn_a_log": jnp.log(jax.random.uniform(ks[11], (DEPTH, GDN_HEADS), F32, 1.0, 16.0)),
        "gdn_dt_bias": dt + jnp.log(-jnp.expm1(-dt)),
        "gdn_norm": gain(ks[13], (DEPTH, HEAD_DIM)),
        "ffn_w_gate": nrm(ks[14], (DEPTH, D_MODEL, D_FF)) * D_MODEL ** -0.5,
        "ffn_w_up": nrm(ks[15], (DEPTH, D_MODEL, D_FF)) * D_MODEL ** -0.5,
        "ffn_w_down": nrm(ks[16], (DEPTH, D_FF, D_MODEL)) * D_FF ** -0.5,
    }


def reference(x, norm_mix_pre, norm_mix_post, norm_ffn_pre, norm_ffn_post, w_in, w_o,
              gla_w_gate, gla_b_gate, gla_norm, gdn_conv, gdn_a_log, gdn_dt_bias, gdn_norm,
              ffn_w_gate, ffn_w_up, ffn_w_down):
    split_points = [int(p) for p in np.cumsum(IN_SPLITS)[:-1]]
    for l in range(DEPTH):
        h = rms_norm(x, norm_mix_pre[l])
        proj = h @ w_in[l]
        (gq, gk, gv, gz, ga, dq, dk, dv, dz, db, da, mq, mk, mv) = jnp.split(
            proj, split_points, axis=-1)
        o_gla = gla_mixer(gq, gk, gv, gz, ga, gla_w_gate[l], gla_b_gate[l], gla_norm[l])
        o_gdn = gdn_mixer(dq, dk, dv, dz, db, da, gdn_conv[l], gdn_a_log[l],
                          gdn_dt_bias[l], gdn_norm[l])
        o_moba = moba_mixer(mq, mk, mv)
        mix = jnp.concatenate([o_gla, o_gdn, o_moba], axis=-1) @ w_o[l]
        x = x + rms_norm(mix, norm_mix_post[l])
        h = rms_norm(x, norm_ffn_pre[l])
        y = (jax.nn.silu(h @ ffn_w_gate[l]) * (h @ ffn_w_up[l])) @ ffn_w_down[l]
        x = x + rms_norm(y, norm_ffn_post[l])
    return x
```

```cpp
#include <hip/hip_runtime.h>
#include <hip/hip_cooperative_groups.h>
#include <cstdio>
#include <cstdint>
#include <cmath>
namespace pg8 {
#define PG8_LAS __attribute__((address_space(3)))
typedef unsigned short bf16_t;
typedef short bf16x8 __attribute__((ext_vector_type(8)));
typedef float f32x4 __attribute__((ext_vector_type(4)));
typedef unsigned u32x4 __attribute__((ext_vector_type(4)));
constexpr int BM = 256, BK = 64, HALF = 128, HTB = HALF * BK * 2  , STAGE_BYTES = 8 * HTB, NXCD = 8, WGM = 8;

__host__ __device__ __forceinline__ int lds_byte(int r, int c) { const int st = (r >> 4) * 2 + (c >> 5), rr = r & 15, cc = c & 31, ob = rr * 64 + cc * 2; return st * 1024 + (ob ^ (((ob >> 9) & 1) << 5)); }
__host__ __device__ __forceinline__ void stage_rc(int b, int& R, int& C) { const int st = b / 1024, sb = b % 1024, swz = sb ^ (((sb >> 9) & 1) << 5); R = (st >> 1) * 16 + swz / 64; C = (st & 1) * 32 + (swz % 64) / 2; }
__host__ __device__ __forceinline__ int perm32(int rho) { const int n = rho >> 4, i = rho & 15; return 8 * (i >> 2) + 4 * n + (i & 3); }

struct Unit { int pm, pn; };
struct Gemm { const bf16_t* A; const bf16_t* Bt; int M, N, K; };

struct StaticOrder {
    int nM, nN, nwg, G, c;
    __host__ __device__ void init(int M, int N, int G_, int c_) { nM = M / BM; nN = N / BM; nwg = nM * nN; G = G_; c = c_; }
    __host__ __device__ bool next(int i, Unit& u) const {
        const long L = (long)i * G + c; if (L >= nwg) return false;
        int wgid = (int)L; { const int q = nwg / NXCD, r = nwg % NXCD, xcd = wgid % NXCD, off = wgid / NXCD; wgid = (xcd < r ? xcd * (q + 1) : r * (q + 1) + (xcd - r) * q) + off; }
        const int nig = WGM * nN, gid = wgid / nig, fm = gid * WGM, gsz = (nM - fm) < WGM ? (nM - fm) : WGM;
        u.pm = fm + ((wgid % nig) % gsz); u.pn = (wgid % nig) / gsz; return true;
    }
    __device__ __forceinline__ void a_ready(const Unit&) const {}
    __device__ __forceinline__ void done(const Unit&) const {}
};

__device__ __forceinline__ unsigned cvt_pk_bf16(float lo, float hi) { unsigned r; asm volatile("v_cvt_pk_bf16_f32 %0, %1, %2" : "=v"(r) : "v"(lo), "v"(hi)); return r; }
typedef float f32x2 __attribute__((ext_vector_type(2)));
struct EpiPlainBf16 {
    static constexpr bool PERM = true, AFTER_DRAIN = false;
    bf16_t* O; int ldc;
    __device__ __forceinline__ void operator()(const f32x4 (&acc)[2][2][4][2], const Unit& u, int wr, int wc, int fr, int fq) const {
        const int row0 = u.pm * BM + wr * 64 + fr, col0 = u.pn * BM + wc * 32 + 8 * fq;
#pragma unroll
        for (int ai = 0; ai < 2; ++ai)
#pragma unroll
            for (int m = 0; m < 4; ++m) { bf16_t* rowp = O + (size_t)(row0 + ai * HALF + m * 16) * ldc + col0;
#pragma unroll
                for (int bj = 0; bj < 2; ++bj) { const f32x4 v0 = acc[ai][bj][m][0], v1 = acc[ai][bj][m][1];
                    u32x4 w; w.x = cvt_pk_bf16(v0[0], v0[1]); w.y = cvt_pk_bf16(v0[2], v0[3]); w.z = cvt_pk_bf16(v1[0], v1[1]); w.w = cvt_pk_bf16(v1[2], v1[3]);
                    *(u32x4*)(rowp + bj * HALF) = w; } }
    }
};
struct EpiInProj {
    static constexpr bool PERM = true, AFTER_DRAIN = false;
    bf16_t* O; float* small; const float* rstd; const float* tab; float* kmean; unsigned* kmaxh;
    __device__ __forceinline__ float bp(float v, int src) const { return __int_as_float(__builtin_amdgcn_ds_bpermute(src << 2, __float_as_int(v))); }
    __device__ __forceinline__ void operator()(const f32x4 (&acc)[2][2][4][2], const Unit& u, int wr, int wc, int fr, int fq) const {
        const int row0 = u.pm * BM + wr * 64 + fr, lane = fr + 16 * fq;
        if (u.pn < 8 || u.pn > 11) {
            const int col0 = u.pn * BM + wc * 32 + 8 * fq;
#pragma unroll
            for (int ai = 0; ai < 2; ++ai)
#pragma unroll
                for (int m = 0; m < 4; ++m) { const int row = row0 + ai * HALF + m * 16; const float rs = rstd[row]; bf16_t* rowp = O + (size_t)row * 3584 + col0;
#pragma unroll
                    for (int bj = 0; bj < 2; ++bj) { const f32x4 v0 = acc[ai][bj][m][0] * rs, v1 = acc[ai][bj][m][1] * rs;
                        u32x4 w; w.x = cvt_pk_bf16(v0[0], v0[1]); w.y = cvt_pk_bf16(v0[2], v0[3]); w.z = cvt_pk_bf16(v1[0], v1[1]); w.w = cvt_pk_bf16(v1[2], v1[3]);
                        *(u32x4*)(rowp + bj * HALF) = w; } }
        } else {
            typedef unsigned u32x2v __attribute__((ext_vector_type(2)));
            const bool isk = u.pn >= 10; const int g = 4 * (wc & 1) + fq;
#pragma unroll
            for (int bj = 0; bj < 2; ++bj) { const int hb = u.pn * BM + bj * HALF + (wc >> 1) * 64;
                f32x4 cs1 = {0.f, 0.f, 0.f, 0.f}, cs2 = {0.f, 0.f, 0.f, 0.f}; float nmax = 0.f;
#pragma unroll
                for (int ai = 0; ai < 2; ++ai)
#pragma unroll
                    for (int m = 0; m < 4; ++m) { const int row = row0 + ai * HALF + m * 16; const float rs = rstd[row]; const f32x4 a = acc[ai][bj][m][0] * rs, c = acc[ai][bj][m][1] * rs;
                        const float* tp = tab + ((size_t)(row & 8191) * 32 + 4 * g) * 2; const f32x4 t0 = *(const f32x4*)tp, t1 = *(const f32x4*)(tp + 4);
                        f32x4 o1, o2; o1[0] = a[0] * t0[0] - c[0] * t0[1]; o2[0] = c[0] * t0[0] + a[0] * t0[1]; o1[1] = a[1] * t0[2] - c[1] * t0[3]; o2[1] = c[1] * t0[2] + a[1] * t0[3];
                        o1[2] = a[2] * t1[0] - c[2] * t1[1]; o2[2] = c[2] * t1[0] + a[2] * t1[1]; o1[3] = a[3] * t1[2] - c[3] * t1[3]; o2[3] = c[3] * t1[2] + a[3] * t1[3];
                        u32x2v w1, w2; w1.x = cvt_pk_bf16(o1[0], o1[1]); w1.y = cvt_pk_bf16(o1[2], o1[3]); w2.x = cvt_pk_bf16(o2[0], o2[1]); w2.y = cvt_pk_bf16(o2[2], o2[3]);
                        bf16_t* rowp = O + (size_t)row * 3584 + hb + 4 * g; *(u32x2v*)rowp = w1; *(u32x2v*)(rowp + 32) = w2;
                        if (isk) { cs1 += o1; cs2 += o2; float n2 = (o1[0] * o1[0] + o1[1] * o1[1]) + (o1[2] * o1[2] + o1[3] * o1[3]) + (o2[0] * o2[0] + o2[1] * o2[1]) + (o2[2] * o2[2] + o2[3] * o2[3]);
                            n2 += bp(n2, lane ^ 16); n2 += bp(n2, lane ^ 32); nmax = fmaxf(nmax, n2); } }
                if (isk) {
#pragma unroll
                    for (int o = 1; o < 16; o <<= 1) {
#pragma unroll
                        for (int k = 0; k < 4; ++k) { cs1[k] += bp(cs1[k], lane ^ o); cs2[k] += bp(cs2[k], lane ^ o); }
                        nmax = fmaxf(nmax, bp(nmax, lane ^ o)); }
                    const int bh = (u.pm >> 5) * 8 + ((hb - 2560) >> 6), nblk = u.pm & 31;
                    if (fr == 0) { float* km = kmean + ((size_t)bh * 32 + nblk) * 64;
#pragma unroll
                        for (int k = 0; k < 4; ++k) { atomicAdd(km + 4 * g + k, cs1[k]); atomicAdd(km + 32 + 4 * g + k, cs2[k]); }
                        if (fq == 0) atomicMax(kmaxh + bh * 2 + (wc & 1), __float_as_uint(nmax)); }
                }
            }
        }
    }
};
struct EpiSwiglu {
    static constexpr bool PERM = true, AFTER_DRAIN = false;
    bf16_t* H; const float* rstd;
    __device__ __forceinline__ void operator()(const f32x4 (&acc)[2][2][4][2], const Unit& u, int wr, int wc, int fr, int fq) const {
        const int row0 = u.pm * BM + wr * 64 + fr, col0 = u.pn * HALF + wc * 32 + 8 * fq;
#pragma unroll
        for (int ai = 0; ai < 2; ++ai)
#pragma unroll
            for (int m = 0; m < 4; ++m) { const int row = row0 + ai * HALF + m * 16; const float rs = rstd[row]; bf16_t* rowp = H + (size_t)row * 2816 + col0;
                float h[8];
#pragma unroll
                for (int n = 0; n < 2; ++n)
#pragma unroll
                    for (int j = 0; j < 4; ++j) { const float g = acc[ai][0][m][n][j] * rs, up = acc[ai][1][m][n][j] * rs;
                        h[n * 4 + j] = g * __builtin_amdgcn_rcpf(1.0f + __expf(-g)) * up; }
                u32x4 w; w.x = cvt_pk_bf16(h[0], h[1]); w.y = cvt_pk_bf16(h[2], h[3]); w.z = cvt_pk_bf16(h[4], h[5]); w.w = cvt_pk_bf16(h[6], h[7]);
                *(u32x4*)rowp = w; }
    }
};
template <class Epi, class Sched, bool ALIGN_EPI = false, bool SP2 = false>
__device__ __forceinline__ void gemm_phase(PG8_LAS unsigned char* lds, const Gemm g, const Sched& S, const Epi& E, int tid_in) {
    int tid_ = tid_in; asm volatile("" : "+v"(tid_)); const int tid = tid_, wid = __builtin_amdgcn_readfirstlane(tid >> 6), lane = tid & 63, wr = wid >> 2, wc = wid & 3, fr = lane & 15, fq = lane >> 4;
    const int K = g.K, nt = K / BK;
    unsigned voffA[2], voffB[2];
#pragma unroll
    for (int i = 0; i < 2; ++i) { int R, C; stage_rc(tid * 16 + i * 8192, R, C); const int Rb = Epi::PERM ? ((R & ~31) + perm32(R & 31)) : R;
        voffA[i] = (unsigned)(R * K + C) * 2u; voffB[i] = (unsigned)(Rb * K + C) * 2u; }
    const size_t kstep = (size_t)(BK * 2);
    const size_t hstep = (size_t)HALF * K * 2;
    const size_t tstep = 2 * hstep;
    const unsigned ldsw = (unsigned)wid * 1024u;
    const int aoff = lds_byte(wr * 64 + fr, fq * 8), boff = lds_byte(wc * 32 + fr, fq * 8);
#define PG8_SA(b, h) (((b) * 2 + (h)) * HTB)
#define PG8_SB(b, h) ((4 + (b) * 2 + (h)) * HTB)
#define PG8_STAGE(bufoff, gbase, voff) do { _Pragma("unroll") for (int _i = 0; _i < 2; ++_i) \
        __builtin_amdgcn_global_load_lds((const unsigned*)((const char*)(gbase) + (voff)[_i]), (PG8_LAS unsigned*)(lds + (bufoff) + ldsw + _i * 8192), 16, 0, 0); } while (0)
#define PG8_LDA(dst, b, h) do { _Pragma("unroll") for (int m = 0; m < 4; ++m) _Pragma("unroll") for (int k = 0; k < 2; ++k) dst[m][k] = *(const PG8_LAS bf16x8*)(lds + PG8_SA(b, h) + aoff + m * 2048 + k * 1024); } while (0)
#define PG8_LDB(dst, b, h) do { _Pragma("unroll") for (int n = 0; n < 2; ++n) _Pragma("unroll") for (int k = 0; k < 2; ++k) dst[n][k] = *(const PG8_LAS bf16x8*)(lds + PG8_SB(b, h) + boff + n * 2048 + k * 1024); } while (0)
#define PG8_MMA(ai, bj, At, Bt) do { __builtin_amdgcn_s_setprio(1); _Pragma("unroll") for (int m = 0; m < 4; ++m) _Pragma("unroll") for (int n = 0; n < 2; ++n) _Pragma("unroll") for (int k = 0; k < 2; ++k) \
        acc[ai][bj][m][n] = __builtin_amdgcn_mfma_f32_16x16x32_bf16(Bt[n][k], At[m][k], acc[ai][bj][m][n], 0, 0, 0); __builtin_amdgcn_s_setprio(0); } while (0)
#define PG8_WAIT_V(n) asm volatile("s_waitcnt vmcnt(" #n ")" ::: "memory")
#define PG8_WAIT_L(n) asm volatile("s_waitcnt lgkmcnt(" #n ")" ::: "memory")
#define PG8_BAR __builtin_amdgcn_s_barrier()
#define PG8_SCHED __builtin_amdgcn_sched_barrier(0)
    Unit cur, nxt; int ui = 0;
    if (!S.next(0, cur)) return;
    f32x4 acc[2][2][4][2];
#pragma unroll
    for (int a = 0; a < 2; ++a)
#pragma unroll
        for (int b = 0; b < 2; ++b)
#pragma unroll
            for (int m = 0; m < 4; ++m)
#pragma unroll
                for (int n = 0; n < 2; ++n) acc[a][b][m][n] = (f32x4){0.f, 0.f, 0.f, 0.f};
    bf16x8 At[4][2], B0[2][2], B1[2][2];
    const char* cA = (const char*)g.A + (size_t)cur.pm * tstep; const char* cB = (const char*)g.Bt + (size_t)cur.pn * tstep;
    S.a_ready(cur);
    if constexpr (SP2) {
        PG8_STAGE(PG8_SB(0, 0), cB, voffB); PG8_STAGE(PG8_SB(0, 1), cB + hstep, voffB); PG8_STAGE(PG8_SA(0, 0), cA, voffA); PG8_STAGE(PG8_SA(0, 1), cA + hstep, voffA);
        if (wr == 1) PG8_BAR;
        PG8_WAIT_V(2); PG8_BAR;
        PG8_STAGE(PG8_SB(1, 0), cB + kstep, voffB); PG8_STAGE(PG8_SA(1, 0), cA + kstep, voffA); PG8_STAGE(PG8_SB(1, 1), cB + hstep + kstep, voffB);
        PG8_WAIT_V(6); PG8_BAR;
    } else {
        PG8_STAGE(PG8_SB(0, 0), cB, voffB); PG8_STAGE(PG8_SA(0, 0), cA, voffA); PG8_STAGE(PG8_SB(0, 1), cB + hstep, voffB); PG8_STAGE(PG8_SA(0, 1), cA + hstep, voffA);
        if (wr == 1) PG8_BAR;
        PG8_WAIT_V(4); PG8_BAR;
        PG8_STAGE(PG8_SB(1, 0), cB + kstep, voffB); PG8_STAGE(PG8_SA(1, 0), cA + kstep, voffA); PG8_STAGE(PG8_SB(1, 1), cB + hstep + kstep, voffB);
        PG8_WAIT_V(6); PG8_BAR;
    }
    for (;;) {
        const bool has_next = S.next(ui + 1, nxt);
        const char* nA = has_next ? (const char*)g.A + (size_t)nxt.pm * tstep : cA; const char* nB = has_next ? (const char*)g.Bt + (size_t)nxt.pn * tstep : cB;
        for (int t = 0; t < nt; t += 2) {
            const bool last = (t == nt - 2);
            const char* a1 = cA + (size_t)(t + 1) * kstep;
            const char* a2 = last ? nA : cA + (size_t)(t + 2) * kstep; const char* b2 = last ? nB : cB + (size_t)(t + 2) * kstep;
            const char* a3 = a2 + kstep; const char* b3 = b2 + kstep;
            if (last && has_next) S.a_ready(nxt);
            if constexpr (SP2) {
            PG8_LDB(B0, 0, 0); PG8_LDB(B1, 0, 1); PG8_SCHED; PG8_LDA(At, 0, 0); PG8_STAGE(PG8_SA(1, 1), a1 + hstep, voffA);
            PG8_WAIT_V(8); PG8_WAIT_L(0); PG8_BAR; PG8_MMA(0, 0, At, B0); PG8_MMA(0, 1, At, B1); PG8_BAR; PG8_SCHED;
            PG8_LDA(At, 0, 1); PG8_STAGE(PG8_SB(0, 0), b2, voffB); PG8_STAGE(PG8_SB(0, 1), b2 + hstep, voffB); PG8_STAGE(PG8_SA(0, 0), a2, voffA);
            PG8_WAIT_V(8); PG8_WAIT_L(0); PG8_BAR; PG8_MMA(1, 0, At, B0); PG8_MMA(1, 1, At, B1); PG8_BAR; PG8_SCHED;
            PG8_LDB(B0, 1, 0); PG8_LDB(B1, 1, 1); PG8_SCHED; PG8_LDA(At, 1, 0); PG8_STAGE(PG8_SA(0, 1), a2 + hstep, voffA);
            PG8_WAIT_V(8); PG8_WAIT_L(0); PG8_BAR; PG8_MMA(0, 0, At, B0); PG8_MMA(0, 1, At, B1); PG8_BAR; PG8_SCHED;
            PG8_LDA(At, 1, 1); PG8_STAGE(PG8_SB(1, 0), b3, voffB); PG8_STAGE(PG8_SB(1, 1), b3 + hstep, voffB); PG8_STAGE(PG8_SA(1, 0), a3, voffA);
            PG8_WAIT_V(8); PG8_WAIT_L(0); PG8_BAR; PG8_MMA(1, 0, At, B0); PG8_MMA(1, 1, At, B1); PG8_BAR; PG8_SCHED;
            } else {
            PG8_LDB(B0, 0, 0); PG8_SCHED; PG8_LDA(At, 0, 0); PG8_STAGE(PG8_SA(1, 1), a1 + hstep, voffA);
            PG8_WAIT_L(8); PG8_BAR; PG8_WAIT_L(0); PG8_MMA(0, 0, At, B0); PG8_BAR; PG8_SCHED;
            PG8_LDB(B1, 0, 1); PG8_STAGE(PG8_SB(0, 0), b2, voffB);
            PG8_BAR; PG8_WAIT_L(0); PG8_MMA(0, 1, At, B1); PG8_BAR;
            PG8_LDA(At, 0, 1); PG8_STAGE(PG8_SA(0, 0), a2, voffA);
            PG8_BAR; PG8_WAIT_L(0); PG8_MMA(1, 0, At, B0); PG8_BAR; PG8_SCHED;
            PG8_STAGE(PG8_SB(0, 1), b2 + hstep, voffB);
            PG8_WAIT_V(6); PG8_BAR; PG8_MMA(1, 1, At, B1); PG8_BAR;
            PG8_LDB(B0, 1, 0); PG8_SCHED; PG8_LDA(At, 1, 0); PG8_STAGE(PG8_SA(0, 1), a2 + hstep, voffA);
            PG8_WAIT_L(8); PG8_BAR; PG8_WAIT_L(0); PG8_MMA(0, 0, At, B0); PG8_BAR; PG8_SCHED;
            PG8_LDB(B1, 1, 1); PG8_STAGE(PG8_SB(1, 0), b3, voffB);
            PG8_BAR; PG8_WAIT_L(0); PG8_MMA(0, 1, At, B1); PG8_BAR;
            PG8_LDA(At, 1, 1); PG8_STAGE(PG8_SA(1, 0), a3, voffA);
            PG8_BAR; PG8_WAIT_L(0); PG8_MMA(1, 0, At, B0); PG8_BAR; PG8_SCHED;
            PG8_STAGE(PG8_SB(1, 1), b3 + hstep, voffB);
            PG8_WAIT_V(6); PG8_BAR; PG8_MMA(1, 1, At, B1); PG8_BAR;
            }
        }
        if constexpr (ALIGN_EPI) { if (wr == 0) PG8_BAR; }
        if constexpr (!Epi::AFTER_DRAIN) { E(acc, cur, wr, wc, fr, fq); S.done(cur); }
        if (!has_next) break;
#pragma unroll
        for (int a = 0; a < 2; ++a)
#pragma unroll
            for (int b = 0; b < 2; ++b)
#pragma unroll
                for (int m = 0; m < 4; ++m)
#pragma unroll
                    for (int n = 0; n < 2; ++n) acc[a][b][m][n] = (f32x4){0.f, 0.f, 0.f, 0.f};
        cur = nxt; cA = nA; cB = nB; ++ui;
        if constexpr (ALIGN_EPI) { if (wr == 1) PG8_BAR; }
    }
    PG8_WAIT_V(0);
    if constexpr (!ALIGN_EPI) { if (wr == 0) PG8_BAR; }
    PG8_BAR;
    if constexpr (Epi::AFTER_DRAIN) { E.fused(acc, cur, wr, wc, fr, fq, lds, wid, lane); S.done(cur); }
#undef PG8_SA
#undef PG8_SB
#undef PG8_STAGE
#undef PG8_LDA
#undef PG8_LDB
#undef PG8_MMA
#undef PG8_WAIT_V
#undef PG8_WAIT_L
#undef PG8_BAR
#undef PG8_SCHED
}
}
namespace cg = cooperative_groups;
constexpr int NWAVES = 8, NTHREADS = 512;
constexpr int BATCH = 4, SEQ = 8192, DM = 1024, MTOK = BATCH * SEQ, DEPTH = 2, NIN = 3608, NINP = 3840, PROJW = 3584, DFF = 2816;
constexpr int PC_GQ = 0, PC_GK = 256, PC_GV = 512, PC_GZ = 768, PC_DQ = 1024, PC_DK = 1280, PC_DV = 1536, PC_DZ = 1792, PC_MQ = 2048, PC_MK = 2560, PC_MV = 3072;
constexpr float RMS_EPS = 1e-6f;
constexpr size_t MiB = 1u << 20;
constexpr size_t WS_CTL = 0, CTL_ZERO_BYTES = 1 * MiB;
constexpr size_t WS_RSTD = 1 * MiB;
constexpr size_t WS_KMEAN = 256 * 1024;
constexpr size_t WS_KMAXH = 768 * 1024;
constexpr size_t WS_TAB = 2 * MiB;
constexpr size_t WS_SMALL = 4 * MiB;
constexpr size_t WS_W = 8 * MiB;
constexpr size_t W_IN_OFF = 0, W_O_OFF = (size_t)NINP * DM * 2, W_GU_OFF = W_O_OFF + (size_t)DM * DM * 2, W_D_OFF = W_GU_OFF + (size_t)2 * DFF * DM * 2, W_LAYER = 26 * MiB;
static_assert(W_D_OFF + (size_t)DM * DFF * 2 <= W_LAYER, "weights per layer");
constexpr size_t WS_XB = 64 * MiB;
constexpr size_t WS_PROJ = 128 * MiB;
constexpr size_t WS_MIX = 352 * MiB;
constexpr size_t WS_END = 416 * MiB;
constexpr int RING_BYTES = 131072, LDS_BYTES = 147456;

#define LAS __attribute__((address_space(3)))
typedef unsigned short bf16;
typedef unsigned v4u __attribute__((ext_vector_type(4)));
typedef unsigned v2u __attribute__((ext_vector_type(2)));
typedef float f32x4 __attribute__((ext_vector_type(4)));
#define LDS_WAIT() asm volatile("s_waitcnt lgkmcnt(0)" ::: "memory")
__device__ __forceinline__ unsigned f2bf(float f) { unsigned u = __builtin_bit_cast(unsigned, f); return (u + 0x7fffu + ((u >> 16) & 1u)) >> 16; }
typedef float f32x2_t __attribute__((ext_vector_type(2))); typedef __bf16 bf16x2_t __attribute__((ext_vector_type(2)));
__device__ __forceinline__ unsigned pk2(float lo, float hi) { const f32x2_t v = {lo, hi}; return __builtin_bit_cast(unsigned, __builtin_convertvector(v, bf16x2_t)); }
__device__ __forceinline__ float bf2f(unsigned short u) { return __builtin_bit_cast(float, (unsigned)u << 16); }
__device__ __forceinline__ float bflo(unsigned u) { return __builtin_bit_cast(float, u << 16); }
__device__ __forceinline__ float bfhi(unsigned u) { return __builtin_bit_cast(float, u & 0xffff0000u); }
__device__ __forceinline__ float bperm(float v, int srclane) { return __int_as_float(__builtin_amdgcn_ds_bpermute(srclane << 2, __float_as_int(v))); }
__device__ __forceinline__ float wave_sum(float v, int lane) {
#pragma unroll
    for (int o = 1; o < 64; o <<= 1) v += bperm(v, lane ^ o);
    return v;
}
__device__ __forceinline__ float wave_max(float v, int lane) {
#pragma unroll
    for (int o = 1; o < 64; o <<= 1) v = fmaxf(v, bperm(v, lane ^ o));
    return v;
}
__device__ __forceinline__ float rl(float v, int l) { return __int_as_float(__builtin_amdgcn_readlane(__float_as_int(v), l)); }
__device__ __forceinline__ float siluf(float z) { return z * __builtin_amdgcn_rcpf(1.f + __expf(-z)); }

struct Args { const float* in[17]; float* out; unsigned char* ws; int pad[2]; };
struct Frame {
    LAS unsigned char* lds; unsigned char* ldsg;
    int tid, lane, wave, G, bid, wave_s, layer;
    unsigned char* ws;
};
__device__ __forceinline__ void refresh(Frame& F, const Args& args) {
    int ln = (int)__builtin_amdgcn_mbcnt_hi(~0u, __builtin_amdgcn_mbcnt_lo(~0u, 0u)); asm volatile("" : "+v"(ln)); int wv = F.wave_s; asm volatile("" : "+s"(wv));
    F.lane = ln; F.wave = wv; F.tid = wv * 64 + ln;
    unsigned char* w = args.ws; asm volatile("" : "+s"(w)); F.ws = w;
    int b = blockIdx.x; asm volatile("" : "+s"(b)); F.bid = b;
}

__device__ __forceinline__ int inproj_src(int dn) {
    if (dn >= 2048 && dn < 3072) { const int hb = dn & ~63, p = dn & 63, g = p >> 3, j = p & 7; return hb + (j < 4 ? 4 * g + j : 32 + 4 * g + (j - 4)) + 24; }
    return dn < 1024 ? dn : dn < 2048 ? dn + 16 : dn < 3584 ? dn + 24 : dn < 3600 ? dn - 3584 + 1024 : dn < 3608 ? dn - 3600 + 2064 : -1; }
__device__ __forceinline__ void transpose_item(const float* W, int K, int N, const float* kscale, bf16* WT, int n0, int src4, int k0, LAS float* scr, int lane) {
    const int kq = lane >> 4, n4 = 4 * (lane & 15);
    f32x4 v[16];
#pragma unroll
    for (int i = 0; i < 16; ++i) { const int kk = 4 * i + kq; v[i] = (f32x4){0.f, 0.f, 0.f, 0.f}; if (src4 >= 0) v[i] = __builtin_nontemporal_load((const f32x4*)(W + (size_t)(k0 + kk) * N + src4)); }
#pragma unroll
    for (int i = 0; i < 16; ++i) { const int kk = 4 * i + kq; const float sc = kscale ? kscale[k0 + kk] : 1.f;
        scr[(n4 + 0) * 65 + kk] = v[i].x * sc; scr[(n4 + 1) * 65 + kk] = v[i].y * sc; scr[(n4 + 2) * 65 + kk] = v[i].z * sc; scr[(n4 + 3) * 65 + kk] = v[i].w * sc; }
    LDS_WAIT(); asm volatile("" ::: "memory");
    const int c = lane & 7;
#pragma unroll
    for (int j = 0; j < 8; ++j) { const int n = (lane >> 3) + 8 * j; const LAS float* sp = scr + n * 65 + 8 * c;
        v4u o; o.x = pk2(sp[0], sp[1]); o.y = pk2(sp[2], sp[3]); o.z = pk2(sp[4], sp[5]); o.w = pk2(sp[6], sp[7]);
        *(v4u*)(WT + (size_t)(n0 + n) * K + k0 + 8 * c) = o; }
    LDS_WAIT(); asm volatile("" ::: "memory");
}
constexpr int W_ITEMS_EARLY = 16 * (NINP / 64) + 16 * 16, W_ITEMS_ALL = W_ITEMS_EARLY + 16 * (2 * DFF / 64) + (DFF / 64) * 16;
__device__ __forceinline__ void p0_weights(Frame& F, const Args& a, int lA, int lB, int w0, int nw, int lo, int hi) {
    LAS float* scr = (LAS float*)(F.lds + F.wave * 16896);
    constexpr int I_IN = 16 * (NINP / 64), I_O = 16 * 16, I_GU = 16 * (2 * DFF / 64);
    const int n4 = 4 * (F.lane & 15);
    for (int it = lo + w0; it < hi; it += nw) {
        const int l = it < W_ITEMS_EARLY ? lA : lB;
        unsigned char* wl = F.ws + WS_W + (size_t)l * W_LAYER;
        int r = it;
        if (r < I_IN) { const int kb = r / (NINP / 64), nb = r % (NINP / 64); transpose_item(a.in[5] + (size_t)l * DM * NIN, DM, NIN, a.in[1] + l * DM, (bf16*)(wl + W_IN_OFF), nb * 64, inproj_src(nb * 64 + n4), kb * 64, scr, F.lane); continue; } r -= I_IN;
        if (r < I_O) { const int kb = r / 16, nb = r % 16; transpose_item(a.in[6] + (size_t)l * DM * DM, DM, DM, nullptr, (bf16*)(wl + W_O_OFF), nb * 64, nb * 64 + n4, kb * 64, scr, F.lane); continue; } r -= I_O;
        if (r < I_GU) { const int kb = r / (2 * DFF / 64), nb = r % (2 * DFF / 64); const int dn = nb * 64; const int pn = dn >> 8, within = dn & 255;
            const float* W = (within < 128 ? a.in[14] : a.in[15]) + (size_t)l * DM * DFF; const int col = pn * 128 + (within & 127) + n4;
            transpose_item(W, DM, DFF, a.in[3] + l * DM, (bf16*)(wl + W_GU_OFF), dn, col, kb * 64, scr, F.lane); continue; } r -= I_GU;
        { const int kb = r / 16, nb = r % 16; transpose_item(a.in[16] + (size_t)l * DFF * DM, DFF, DM, nullptr, (bf16*)(wl + W_D_OFF), nb * 64, nb * 64 + n4, kb * 64, scr, F.lane); }
    }
}
__device__ __forceinline__ void p0_table(Frame& F) {
    float* tab = (float*)(F.ws + WS_TAB);
    for (int idx = F.bid * NTHREADS + F.tid; idx < SEQ * 32; idx += F.G * NTHREADS) {
        const int pos = idx >> 5, i = idx & 31;
        const float inv = powf(10000.f, -(float)i / 32.f); const float ang = (float)pos * inv;
        tab[2 * idx] = cosf(ang); tab[2 * idx + 1] = sinf(ang);
    }
}
constexpr int NORM_RB = 8;
__device__ __forceinline__ void p0_xb(Frame& F, const float* x, bf16* XB) {
    float* RSTD = (float*)(F.ws + WS_RSTD);
    const int gw = F.bid * NWAVES + F.wave, NGW = F.G * NWAVES;
    for (int m0 = gw * NORM_RB; m0 < MTOK; m0 += NGW * NORM_RB) {
        f32x4 v[NORM_RB][4];
#pragma unroll
        for (int u = 0; u < NORM_RB; ++u) { const f32x4* xr = (const f32x4*)(x + (size_t)(m0 + u) * DM) + F.lane;
#pragma unroll
            for (int j = 0; j < 4; ++j) v[u][j] = __builtin_nontemporal_load(xr + 64 * j); }
#pragma unroll
        for (int u = 0; u < NORM_RB; ++u) { float s = 0.f;
#pragma unroll
            for (int j = 0; j < 4; ++j) s += (v[u][j].x * v[u][j].x + v[u][j].y * v[u][j].y) + (v[u][j].z * v[u][j].z + v[u][j].w * v[u][j].w);
            s = wave_sum(s, F.lane);
            v2u* o = (v2u*)(XB + (size_t)(m0 + u) * DM) + F.lane;
#pragma unroll
            for (int j = 0; j < 4; ++j) { v2u w; w.x = pk2(v[u][j].x, v[u][j].y); w.y = pk2(v[u][j].z, v[u][j].w); o[64 * j] = w; }
            if (F.lane == 0) RSTD[m0 + u] = rsqrtf(s * (1.f / DM) + RMS_EPS); }
    }
}
__device__ __forceinline__ void norm_pass(Frame& F, const bf16* rsrc, bf16* rdst, float* out, const float* w, bool last) {
    const bf16* Y = (const bf16*)(F.ws + WS_XB); float* RSTD = (float*)(F.ws + WS_RSTD);
    const int gw = F.bid * NWAVES + F.wave, NGW = F.G * NWAVES;
    f32x4 wv[4];
#pragma unroll
    for (int j = 0; j < 4; ++j) wv[j] = ((const f32x4*)w)[64 * j + F.lane];
    for (int m0 = gw * NORM_RB; m0 < MTOK; m0 += NGW * NORM_RB) {
        v2u yu[NORM_RB][4], xu[NORM_RB][4];
#pragma unroll
        for (int u = 0; u < NORM_RB; ++u) { const v2u* yr = (const v2u*)(Y + (size_t)(m0 + u) * DM) + F.lane; const v2u* xr = (const v2u*)(rsrc + (size_t)(m0 + u) * DM) + F.lane;
#pragma unroll
            for (int j = 0; j < 4; ++j) { yu[u][j] = __builtin_nontemporal_load(yr + 64 * j); xu[u][j] = __builtin_nontemporal_load(xr + 64 * j); } }
#pragma unroll
        for (int u = 0; u < NORM_RB; ++u) { f32x4 y[4], xv[4]; float s = 0.f;
#pragma unroll
            for (int j = 0; j < 4; ++j) { y[j] = (f32x4){bflo(yu[u][j].x), bfhi(yu[u][j].x), bflo(yu[u][j].y), bfhi(yu[u][j].y)}; s += (y[j].x * y[j].x + y[j].y * y[j].y) + (y[j].z * y[j].z + y[j].w * y[j].w); }
            s = wave_sum(s, F.lane); const float r = rsqrtf(s * (1.f / DM) + RMS_EPS); float s2 = 0.f;
#pragma unroll
            for (int j = 0; j < 4; ++j) { xv[j] = (f32x4){bflo(xu[u][j].x), bfhi(xu[u][j].x), bflo(xu[u][j].y), bfhi(xu[u][j].y)} + y[j] * r * wv[j]; s2 += (xv[j].x * xv[j].x + xv[j].y * xv[j].y) + (xv[j].z * xv[j].z + xv[j].w * xv[j].w); }
            if (last) { f32x4* xo = (f32x4*)(out + (size_t)(m0 + u) * DM) + F.lane;
#pragma unroll
                for (int j = 0; j < 4; ++j) __builtin_nontemporal_store(xv[j], xo + 64 * j); }
            else { s2 = wave_sum(s2, F.lane); v2u* o = (v2u*)(rdst + (size_t)(m0 + u) * DM) + F.lane;
#pragma unroll
                for (int j = 0; j < 4; ++j) { v2u wq; wq.x = pk2(xv[j].x, xv[j].y); wq.y = pk2(xv[j].z, xv[j].w); o[64 * j] = wq; }
                if (F.lane == 0) RSTD[m0 + u] = rsqrtf(s2 * (1.f / DM) + RMS_EPS); } }
    }
}
#define XB_TMO      128
#define XB_XCNT(j)  (256  + 64 * (j))
#define XB_XSUB(j)  (1280 + 64 * (j))
#define XB_XGEN(j)  (2304 + 64 * (j))
#define XB_TOP      3328
#define XB_TOPGEN   3392
#define XCD_BAR_WORDS 3456
#define XB_SPIN_CAP (1u << 22)

__device__ __forceinline__ unsigned xb_ld(unsigned* p)              { return __hip_atomic_load(p, __ATOMIC_RELAXED, __HIP_MEMORY_SCOPE_AGENT); }
__device__ __forceinline__ unsigned xb_add(unsigned* p, unsigned v) { return __hip_atomic_fetch_add(p, v, __ATOMIC_RELAXED, __HIP_MEMORY_SCOPE_AGENT); }
__device__ __forceinline__ unsigned xb_xcc_id() { return (unsigned)__builtin_amdgcn_s_getreg((3 << 11) | 20) & 0xFu; }
#define XB_SPIN(cond, bar) do { unsigned _sp = 0; while (cond) { __builtin_amdgcn_s_sleep(1); \
    if ((++_sp & 255u) == 0u) { if (xb_ld(&(bar)[XB_TMO])) break; if (_sp > XB_SPIN_CAP) { atomicAdd(&(bar)[XB_TMO], 1u); break; } } } } while (0)

struct XcdBarrier {
    unsigned* bar; unsigned x;
    volatile LAS unsigned* st;
};

__device__ __forceinline__ XcdBarrier xcd_barrier_post(unsigned* bar, volatile LAS unsigned* st) {
    XcdBarrier b; b.bar = bar; b.x = xb_xcc_id(); b.st = st;
    if (threadIdx.x == 0) (void)xb_add(&bar[XB_XCNT(b.x)], 1u);
    return b;
}
__device__ __forceinline__ void xcd_barrier_complete(unsigned* bar, unsigned x, unsigned& nloc, unsigned& nx) {
    const unsigned G = gridDim.x * gridDim.y * gridDim.z;
    unsigned sum, cnt, mine, sp = 0u;
    for (;;) {
        sum = 0u; cnt = 0u; mine = 0u;
#pragma unroll
        for (unsigned j = 0; j < 16; ++j) { const unsigned c = xb_ld(&bar[XB_XCNT(j)]); sum += c; cnt += (c > 0u) ? 1u : 0u; mine = (j == x) ? c : mine; }
        if (sum == G) break;
        __builtin_amdgcn_s_sleep(1);
        if ((++sp & 255u) == 0u) { if (xb_ld(&bar[XB_TMO])) break; if (sp > XB_SPIN_CAP) { atomicAdd(&bar[XB_TMO], 1u); break; } }
    }
    nloc = mine > 0u ? mine : 1u; nx = cnt > 0u ? cnt : 1u;
}

__device__ __forceinline__ void xcd_barrier(const XcdBarrier& b) {
    asm volatile("s_waitcnt vmcnt(0)" ::: "memory");
    __syncthreads();
    if (threadIdx.x == 0) {
        unsigned* bar = b.bar;
        __builtin_amdgcn_s_waitcnt(0);
        unsigned nloc = b.st[0], nx = b.st[1];
        if (nloc == 0u) { xcd_barrier_complete(bar, b.x, nloc, nx); b.st[0] = nloc; b.st[1] = nx; }
        const unsigned old = xb_add(&bar[XB_XSUB(b.x)], 1u);
        const unsigned gen = old / nloc;
        if (old + 1u == (gen + 1u) * nloc) {
            __builtin_amdgcn_fence(__ATOMIC_RELEASE, "agent");
            asm volatile("s_waitcnt vmcnt(0)" ::: "memory");
            const unsigned og = xb_add(&bar[XB_TOP], 1u);
            const unsigned tg = og / nx;
            if (og + 1u == (tg + 1u) * nx) xb_add(&bar[XB_TOPGEN], 1u);
            else XB_SPIN(xb_ld(&bar[XB_TOPGEN]) == tg, bar);
            __builtin_amdgcn_fence(__ATOMIC_ACQUIRE, "agent");
            xb_add(&bar[XB_XGEN(b.x)], 1u);
            asm volatile("s_waitcnt vmcnt(0)" ::: "memory");
        } else {
            XB_SPIN(xb_ld(&bar[XB_XGEN(b.x)]) == gen, bar);
            __builtin_amdgcn_fence(__ATOMIC_ACQUIRE, "agent");
            asm volatile("s_waitcnt vmcnt(0)" ::: "memory");
        }
    }
    __syncthreads();
}
typedef short bf16x8 __attribute__((ext_vector_type(8)));
typedef float f32x16 __attribute__((ext_vector_type(16)));
constexpr size_t WS_GLA_S = 416 * MiB;
constexpr size_t WS_GDN_M = 432 * MiB;
constexpr size_t WS_GDN_N = 448 * MiB;
__device__ __forceinline__ int gdn_slot(int item) { return item; }
constexpr size_t WS_GLA_DEC = 464 * MiB;
constexpr size_t WS_GDN_GB = 465 * MiB;
constexpr size_t WS_END2 = 468 * MiB;
constexpr size_t WS_GDN_QC = WS_XB, WS_GDN_KN = WS_XB + 16 * MiB, WS_GDN_W = WS_XB + 32 * MiB, WS_GDN_UT = WS_XB + 48 * MiB;

typedef __attribute__((address_space(1))) unsigned short GBF;
template <typename T> __device__ __forceinline__ T* opq_ptr(T* p) { asm volatile("" : "+v"(p)); return p; }
__device__ __forceinline__ f32x16 mfma32(bf16x8 a, bf16x8 b, f32x16 c) { return __builtin_amdgcn_mfma_f32_32x32x16_bf16(a, b, c, 0, 0, 0); }
__device__ __forceinline__ int crow(int reg, int hh) { return (reg & 3) + 8 * (reg >> 2) + 4 * hh; }
__device__ __forceinline__ bf16x8 mk8(unsigned a, unsigned b, unsigned c, unsigned d) { v4u t = {a, b, c, d}; return __builtin_bit_cast(bf16x8, t); }
__device__ __forceinline__ bf16x8 acc_frag(const f32x16& x, int s) {
    return mk8(pk2(x[8 * s + 0], x[8 * s + 1]), pk2(x[8 * s + 2], x[8 * s + 3]), pk2(x[8 * s + 4], x[8 * s + 5]), pk2(x[8 * s + 6], x[8 * s + 7]));
}
__device__ __forceinline__ void tok_frags(const unsigned (&pk)[32], int ks, bf16x8& f0, bf16x8& f1) {
    unsigned a[4], b[4];
#pragma unroll
    for (int q = 0; q < 4; ++q) { auto rr = __builtin_amdgcn_permlane32_swap(pk[8 * ks + q], pk[8 * ks + 4 + q], false, false); a[q] = rr[0]; b[q] = rr[1]; }
    f0 = mk8(a[0], a[1], a[2], a[3]); f1 = mk8(b[0], b[1], b[2], b[3]);
}
__device__ __forceinline__ void store_acc_order(bf16* base, const f32x16 (&acc)[2][2], int lane) {
#pragma unroll
    for (int nb = 0; nb < 2; ++nb)
#pragma unroll
        for (int mb = 0; mb < 2; ++mb)
#pragma unroll
            for (int g = 0; g < 4; ++g) { v2u w; w.x = pk2(acc[mb][nb][4 * g], acc[mb][nb][4 * g + 1]); w.y = pk2(acc[mb][nb][4 * g + 2], acc[mb][nb][4 * g + 3]);
                *(v2u*)(base + ((nb * 2 + mb) * 4 + g) * 256 + lane * 4) = w; }
}
__device__ __forceinline__ bf16x8 load_acc_frag(const bf16* base, int nb, int mb, int s, int lane) {
    const v2u lo = *(const v2u*)(base + ((nb * 2 + mb) * 4 + 2 * s) * 256 + lane * 4), hi = *(const v2u*)(base + ((nb * 2 + mb) * 4 + 2 * s + 1) * 256 + lane * 4);
    return mk8(lo.x, lo.y, hi.x, hi.y);
}
__device__ __forceinline__ void store_row32_wide(bf16* blk, const v2u (&pkd)[4], int hh) {
#pragma unroll
    for (int gp = 0; gp < 4; gp += 2) { const auto rx = __builtin_amdgcn_permlane32_swap(pkd[gp].x, pkd[gp + 1].x, false, false), ry = __builtin_amdgcn_permlane32_swap(pkd[gp].y, pkd[gp + 1].y, false, false);
        v4u w = {rx[0], ry[0], rx[1], ry[1]}; *(v4u*)(blk + 8 * gp + 8 * hh) = w; }
}
__device__ __forceinline__ bf16x8 load_row_frag(const bf16* p) { const v2u lo = *(const v2u*)p, hi = *(const v2u*)(p + 8); return mk8(lo.x, lo.y, hi.x, hi.y); }

typedef float f32x4m __attribute__((ext_vector_type(4)));
__device__ __forceinline__ void small_proj_tile(Frame& F, const bf16* XBp, const bf16* Win, const float* rstd, int tile) {
    int lane_ = F.lane; asm volatile("" : "+v"(lane_)); const int lane = lane_, fr = lane & 15, fq = lane >> 4;
    const bf16* ap = XBp + (size_t)(tile * 16 + fr) * DM + 8 * fq;
    const bf16* bp0 = Win + (size_t)(3584 + fr) * DM + 8 * fq; const bf16* bp1 = Win + (size_t)(3600 + fr) * DM + 8 * fq;
    f32x4m acc0 = {0.f, 0.f, 0.f, 0.f}, acc1 = {0.f, 0.f, 0.f, 0.f};
#pragma unroll 8
    for (int ks = 0; ks < 32; ++ks) { const bf16x8 a = *(const bf16x8*)(ap + 32 * ks), b0 = *(const bf16x8*)(bp0 + 32 * ks), b1 = *(const bf16x8*)(bp1 + 32 * ks);
        acc0 = __builtin_amdgcn_mfma_f32_16x16x32_bf16(a, b0, acc0, 0, 0, 0); acc1 = __builtin_amdgcn_mfma_f32_16x16x32_bf16(a, b1, acc1, 0, 0, 0); }
    float* SM = (float*)(F.ws + WS_SMALL);
#pragma unroll
    for (int q = 0; q < 4; ++q) { const int row = tile * 16 + 4 * fq + q; const float rs = rstd[row];
        SM[(size_t)row * 32 + fr] = acc0[q] * rs; if (fr < 8) SM[(size_t)row * 32 + 16 + fr] = acc1[q] * rs; }
}
constexpr int JUNK_OFF = 135168;
__device__ __forceinline__ void warm_block(Frame& F, const void* base, size_t pitch, int rows, int lane) {
    LAS unsigned* junk = (LAS unsigned*)(F.lds + JUNK_OFF + F.wave * 1024);
    const unsigned char* p = (const unsigned char*)base + (size_t)(lane >> 3) * pitch + (lane & 7) * 16;
    for (int r = 0; r < rows; r += 8) { if (r + (lane >> 3) < rows) __builtin_amdgcn_global_load_lds((const unsigned*)(p + (size_t)r * pitch), junk, 16, 0, 0); }
}
__device__ __forceinline__ void gla_a_warm(Frame& F, int item) {
    const int c = item & 127, bh = item >> 7, h = bh & 3, b = bh >> 2, lane = F.lane; const size_t r0 = (size_t)b * SEQ + (size_t)c * 64;
    const bf16* wb = (const bf16*)(F.ws + WS_PROJ) + r0 * PROJW + h * 64;
    warm_block(F, (const float*)(F.ws + WS_SMALL) + r0 * 32, 128, 64, lane); warm_block(F, wb + PC_GK, PROJW * 2, 64, lane); warm_block(F, wb + PC_GQ, PROJW * 2, 64, lane); warm_block(F, wb + PC_GV, PROJW * 2, 64, lane);
}
template <bool DRY>
__device__ __forceinline__ void gla_a_item_t(Frame& F, const Args& a, int l, int item) {
    const int c = item & 127, bh = item >> 7, h = bh & 3, b = bh >> 2; int lane_ = F.lane; asm volatile("" : "+v"(lane_)); const int lane = lane_;
    const size_t r0 = (size_t)b * SEQ + (size_t)c * 64;
    bf16* PR = (bf16*)(F.ws + WS_PROJ) + r0 * PROJW + h * 64 + lane;
    const __attribute__((address_space(1))) float* SM = (const __attribute__((address_space(1))) float*)(F.ws + WS_SMALL) + r0 * 32;
    float wg[16];
#pragma unroll
    for (int r = 0; r < 16; ++r) wg[r] = a.in[7][(size_t)l * 4096 + r * 256 + h * 64 + lane];
    const float bias = a.in[8][l * 256 + h * 64 + lane];
    float cum[64]; float run = 0.f;
#pragma unroll
    for (int t = 0; t < 64; ++t) { float s = bias;
#pragma unroll
        for (int r = 0; r < 16; ++r) s = fmaf(SM[t * 32 + r], wg[r], s);
        run += (fminf(s, 0.f) - __logf(1.f + __expf(-fabsf(s)))) * (1.f / 16.f); cum[t] = run; }
    const float last = run;
    unsigned kk[32], vv[32];
#define GLA_A_QUARTER(Q) { unsigned short kr[16], qr[16], vr[16]; GBF* PRt = (GBF*)PR + (size_t)(16 * (Q)) * PROJW; \
        _Pragma("unroll") for (int i = 0; i < 16; ++i) { kr[i] = PRt[PC_GK]; qr[i] = PRt[PC_GQ]; vr[i] = PRt[PC_GV]; PRt = opq_ptr(PRt + PROJW); } \
        GBF* PRs = (GBF*)PR + (size_t)(16 * (Q)) * PROJW; \
        _Pragma("unroll") for (int i2 = 0; i2 < 8; ++i2) { float k2[2]; \
            _Pragma("unroll") for (int u = 0; u < 2; ++u) { const int i = 2 * i2 + u, t = 16 * (Q) + i; GBF* p = PRs; PRs = opq_ptr(PRs + PROJW); const float kf = bf2f(kr[i]), qf = bf2f(qr[i]); \
                { const bf16 q_ = (bf16)f2bf(qf * 0.125f * __expf(cum[t])), k_ = (bf16)f2bf(kf * __expf(-cum[t])); if (DRY) { asm volatile("" :: "v"((unsigned)q_), "v"((unsigned)k_)); } else { p[PC_GQ] = q_; p[PC_GK] = k_; } } k2[u] = kf * __expf(last - cum[t]); } \
            kk[8 * (Q) + i2] = pk2(k2[0], k2[1]); vv[8 * (Q) + i2] = (unsigned)vr[2 * i2] | ((unsigned)vr[2 * i2 + 1] << 16); } \
        asm volatile("" ::: "memory"); }
    GLA_A_QUARTER(0) GLA_A_QUARTER(1) GLA_A_QUARTER(2) GLA_A_QUARTER(3)
#undef GLA_A_QUARTER
    { bf16* vtp = (bf16*)(F.ws + WS_PROJ) + (r0 + lane) * PROJW + PC_GV + h * 64;
#pragma unroll
      for (int q = 0; q < 8; ++q) { v4u o = {vv[4 * q], vv[4 * q + 1], vv[4 * q + 2], vv[4 * q + 3]}; if (!DRY) *(v4u*)(vtp + 8 * q) = o; } }
    ((float*)(F.ws + WS_GLA_DEC))[(size_t)item * 64 + lane] = __expf(last);
    f32x16 acc[2][2];
#pragma unroll
    for (int i = 0; i < 2; ++i)
#pragma unroll
        for (int j = 0; j < 2; ++j)
#pragma unroll
            for (int r = 0; r < 16; ++r) acc[i][j][r] = 0.f;
#pragma unroll
    for (int ks = 0; ks < 4; ++ks) { bf16x8 ka[2], vb[2]; tok_frags(kk, ks, ka[0], ka[1]); tok_frags(vv, ks, vb[0], vb[1]);
#pragma unroll
        for (int mb = 0; mb < 2; ++mb)
#pragma unroll
            for (int nb = 0; nb < 2; ++nb) acc[mb][nb] = mfma32(ka[mb], vb[nb], acc[mb][nb]); }
    store_acc_order((bf16*)(F.ws + WS_GLA_S) + (size_t)item * 4096, acc, lane);
}
__device__ __forceinline__ void gla_a_item(Frame& F, const Args& a, int l, int item) { gla_a_item_t<false>(F, a, l, item); }
__device__ __forceinline__ void gla_scan(Frame& F, int gidx) {
    const int bh = gidx >> 10, within = gidx & 1023, L = within & 63, g = (within >> 6) & 3, mb = (within >> 8) & 1;
    const int d0 = 32 * mb + 8 * g + 4 * (L >> 5);
    bf16* base = (bf16*)(F.ws + WS_GLA_S) + (size_t)bh * 128 * 4096 + within * 4; const float* dec = (const float*)(F.ws + WS_GLA_DEC) + (size_t)bh * 128 * 64 + d0;
    f32x4 S = {0.f, 0.f, 0.f, 0.f};
    for (int c0 = 0; c0 < 128; c0 += 16) {
        v2u ds[16]; f32x4 dc[16];
#pragma unroll
        for (int u = 0; u < 16; ++u) { ds[u] = *(const v2u*)(base + (size_t)(c0 + u) * 4096); dc[u] = *(const f32x4*)(dec + (size_t)(c0 + u) * 64); }
#pragma unroll
        for (int u = 0; u < 16; ++u) { v2u w; w.x = pk2(S.x, S.y); w.y = pk2(S.z, S.w); *(v2u*)(base + (size_t)(c0 + u) * 4096) = w;
            S.x = fmaf(dc[u].x, S.x, bflo(ds[u].x)); S.y = fmaf(dc[u].y, S.y, bfhi(ds[u].x)); S.z = fmaf(dc[u].z, S.z, bflo(ds[u].y)); S.w = fmaf(dc[u].w, S.w, bfhi(ds[u].y)); }
    }
}
__device__ __forceinline__ void gla_c_item(Frame& F, const Args& a, int l, int item) {
    const int c = item & 127, bh = item >> 7, h = bh & 3, b = bh >> 2; int lane_ = F.lane; asm volatile("" : "+v"(lane_)); const int lane = lane_, r = lane & 31, hh = lane >> 5;
    const size_t r0 = (size_t)b * SEQ + (size_t)c * 64;
    const bf16* PR = (const bf16*)(F.ws + WS_PROJ) + r0 * PROJW + h * 64;
    const bf16* Sb = (const bf16*)(F.ws + WS_GLA_S) + (size_t)item * 4096;
    bf16x8 qf[2][2][2], kf[2][2][2];
#pragma unroll
    for (int ib = 0; ib < 2; ++ib)
#pragma unroll
        for (int mb = 0; mb < 2; ++mb)
#pragma unroll
            for (int s = 0; s < 2; ++s) { const size_t off = (size_t)(r + 32 * ib) * PROJW + 32 * mb + 16 * s + 4 * hh;
                qf[ib][mb][s] = load_row_frag(PR + off + PC_GQ); kf[ib][mb][s] = load_row_frag(PR + off + PC_GK); }
    f32x16 pt[2][2], ot[2][2];
#pragma unroll
    for (int i = 0; i < 2; ++i)
#pragma unroll
        for (int j = 0; j < 2; ++j)
#pragma unroll
            for (int q = 0; q < 16; ++q) { pt[i][j][q] = 0.f; ot[i][j][q] = 0.f; }
#pragma unroll
    for (int jb = 0; jb < 2; ++jb)
#pragma unroll
        for (int ib = 0; ib < 2; ++ib) { if (jb == 1 && ib == 0) continue;
#pragma unroll
            for (int mb = 0; mb < 2; ++mb)
#pragma unroll
                for (int s = 0; s < 2; ++s) pt[jb][ib] = mfma32(kf[jb][mb][s], qf[ib][mb][s], pt[jb][ib]); }
#pragma unroll
    for (int q = 0; q < 16; ++q) { if (crow(q, hh) > r) { pt[0][0][q] = 0.f; pt[1][1][q] = 0.f; } }
#pragma unroll
    for (int eb = 0; eb < 2; ++eb)
#pragma unroll
        for (int mb = 0; mb < 2; ++mb)
#pragma unroll
            for (int s = 0; s < 2; ++s) { const bf16x8 sf = load_acc_frag(Sb, eb, mb, s, lane);
#pragma unroll
                for (int ib = 0; ib < 2; ++ib) ot[eb][ib] = mfma32(sf, qf[ib][mb][s], ot[eb][ib]); }
#pragma unroll
    for (int jb = 0; jb < 2; ++jb)
#pragma unroll
        for (int s = 0; s < 2; ++s) {
            bf16x8 vf[2];
#pragma unroll
            for (int eb = 0; eb < 2; ++eb) vf[eb] = load_row_frag(PR + (size_t)(r + 32 * eb) * PROJW + PC_GV + 32 * jb + 16 * s + 4 * hh);
#pragma unroll
            for (int ib = 0; ib < 2; ++ib) { if (jb == 1 && ib == 0) continue; const bf16x8 pf = acc_frag(pt[jb][ib], s);
#pragma unroll
                for (int eb = 0; eb < 2; ++eb) ot[eb][ib] = mfma32(vf[eb], pf, ot[eb][ib]); }
        }
    const float* nw = a.in[9] + l * 64; bf16* MIXp = (bf16*)(F.ws + WS_MIX);
#pragma unroll
    for (int ib = 0; ib < 2; ++ib) { float ss = 0.f;
#pragma unroll
        for (int eb = 0; eb < 2; ++eb)
#pragma unroll
            for (int q = 0; q < 16; ++q) ss = fmaf(ot[eb][ib][q], ot[eb][ib][q], ss);
        ss += bperm(ss, lane ^ 32); const float rs = rsqrtf(ss * (1.f / 64.f) + RMS_EPS);
        const size_t row = r0 + r + 32 * ib;
#pragma unroll
        for (int eb = 0; eb < 2; ++eb) { v2u pkd[4];
#pragma unroll
            for (int g = 0; g < 4; ++g) { const int e0 = 32 * eb + 8 * g + 4 * hh;
                const v2u zz = *(const v2u*)(PR + (size_t)(r + 32 * ib) * PROJW + PC_GZ + e0); const f32x4 w4 = *(const f32x4*)(nw + e0);
                const float y0 = ot[eb][ib][4 * g] * rs * w4.x * siluf(bflo(zz.x)), y1 = ot[eb][ib][4 * g + 1] * rs * w4.y * siluf(bfhi(zz.x));
                const float y2 = ot[eb][ib][4 * g + 2] * rs * w4.z * siluf(bflo(zz.y)), y3 = ot[eb][ib][4 * g + 3] * rs * w4.w * siluf(bfhi(zz.y));
                pkd[g].x = pk2(y0, y1); pkd[g].y = pk2(y2, y3); }
            store_row32_wide(MIXp + row * DM + h * 64 + 32 * eb, pkd, hh); }
    }
}
constexpr int GDN_TAB_OFF = 131072;
#ifndef GDN_LOCKSTEP
#define GDN_LOCKSTEP 1
#endif
#if GDN_LOCKSTEP
#define GDN_LSYNC() __builtin_amdgcn_s_barrier()
#else
#define GDN_LSYNC() do {} while (0)
#endif
__device__ __forceinline__ float wave_incl_scan(float v, int lane) {
#pragma unroll
    for (int o = 1; o < 64; o <<= 1) { const float n = bperm(v, lane - o); if (lane >= o) v += n; }
    return v;
}
__device__ __forceinline__ void gdn_solve64(float (&X)[64], const LAS float* Lm) {
#pragma unroll
    for (int t = 0; t < 64; ++t) asm volatile("" : "+v"(X[t]));
#pragma unroll
    for (int i = 1; i < 64; ++i) {
#pragma unroll
        for (int jg = 0; jg < (i + 3) / 4; ++jg) { const f32x4 l4 = *(const LAS f32x4*)(Lm + i * 64 + 4 * jg);
#pragma unroll
            for (int jj = 0; jj < 4; ++jj) { const int j = 4 * jg + jj; if (j < i) X[i] = fmaf(-l4[jj], X[j], X[i]); } }
    }
#pragma unroll
    for (int t = 0; t < 64; ++t) asm volatile("" : "+v"(X[t]));
}
#define GDN_CONV_HALF(COLOFF, OUT, HF) { float x_[35]; const GBF* p_ = (const GBF*)PRq + (ptrdiff_t)(32 * (HF) - 3) * PROJW + (COLOFF); \
        _Pragma("unroll") for (int i_ = 0; i_ < 35; ++i_) { const int t_ = 32 * (HF) + i_ - 3; \
            if (t_ < 0) { const GBF* q_ = first ? (const GBF*)PRq + (COLOFF) : p_; const float v_ = bf2f(*q_); x_[i_] = first ? 0.f : v_; } else x_[i_] = bf2f(*p_); \
            p_ = opq_ptr(p_ + PROJW); } \
        _Pragma("unroll") for (int i_ = 0; i_ < 32; ++i_) { const int t = 32 * (HF) + i_; const float val = siluf(c0_ * x_[i_] + c1_ * x_[i_ + 1] + c2_ * x_[i_ + 2] + c3_ * x_[i_ + 3]); OUT; } \
        asm volatile("" ::: "memory"); }
#define GDN_CONV_PASS(COLOFF, OUT) do { const float c0_ = cw[(COLOFF)], c1_ = cw[768 + (COLOFF)], c2_ = cw[2 * 768 + (COLOFF)], c3_ = cw[3 * 768 + (COLOFF)]; \
    GDN_CONV_HALF(COLOFF, OUT, 0) GDN_CONV_HALF(COLOFF, OUT, 1) } while (0)
__device__ __forceinline__ void gdn_a_warm(Frame& F, int item) {
    const int c = item & 127, bh = item >> 7, h = bh & 3, b = bh >> 2, lane = F.lane; const size_t r0 = (size_t)b * SEQ + (size_t)c * 64;
    const bf16* wb = (const bf16*)(F.ws + WS_PROJ) + (r0 - (c ? 3 : 0)) * PROJW + PC_DQ + h * 64; const int nr = c ? 67 : 64;
    warm_block(F, wb + 256, PROJW * 2, nr, lane); warm_block(F, wb, PROJW * 2, nr, lane); warm_block(F, wb + 512, PROJW * 2, nr, lane); warm_block(F, (const float*)(F.ws + WS_SMALL) + r0 * 32, 128, 64, lane);
}
__device__ __forceinline__ void gdn_a_item(Frame& F, const Args& a, int l, int item) {
    const int c = item & 127, bh = item >> 7, h = bh & 3, b = bh >> 2; int lane_ = F.lane; asm volatile("" : "+v"(lane_)); const int lane = lane_, r = lane & 31, hh = lane >> 5;
    const size_t r0 = (size_t)b * SEQ + (size_t)c * 64;
    const bf16* PRq = (const bf16*)(F.ws + WS_PROJ) + r0 * PROJW + PC_DQ + h * 64 + lane;
    const float* SM = (const float*)(F.ws + WS_SMALL) + r0 * 32;
    LAS float* Lm = (LAS float*)(F.lds + F.wave * 16384);
    LAS bf16* KT = (LAS bf16*)(F.lds + F.wave * 16384);
    LAS float* tabg = (LAS float*)(F.lds + GDN_TAB_OFF + F.wave * 512); LAS float* tabrb = tabg + 64;
    const float* cw = a.in[10] + (size_t)l * 4 * 768 + h * 64 + lane;
    const float Aexp = __expf(a.in[11][l * 4 + h]), dtb = a.in[12][l * 4 + h];
    float beta_l, gam_l;
    { const float braw = SM[lane * 32 + 16 + h], araw = SM[lane * 32 + 20 + h] + dtb;
      beta_l = 1.f / (1.f + __expf(-braw)); const float sp = araw > 20.f ? araw : log1pf(__expf(araw)); gam_l = wave_incl_scan(-Aexp * sp, lane); }
    const float gam_last = rl(gam_l, 63);
    { float* GB = (float*)(F.ws + WS_GDN_GB) + (r0 + lane) * 8; GB[h] = gam_l; GB[4 + h] = beta_l; }
    const bool first = (c == 0);
    { GBF* QC = (GBF*)(F.ws + WS_GDN_QC) + r0 * 256 + h * 64 + lane;
      GDN_CONV_PASS(0, (void)t; *QC = (bf16)f2bf(val); QC = opq_ptr(QC + 256)); }
    float w[64];
    GDN_LSYNC();
    GDN_CONV_PASS(256, w[t] = val);
    GDN_LSYNC();
#pragma unroll
    for (int t = 0; t < 64; ++t) KT[t * 72 + lane] = (bf16)f2bf(w[t]);
    LDS_WAIT(); asm volatile("" ::: "memory");
    float rn_l;
    { float ss = 0.f;
#pragma unroll
      for (int q = 0; q < 8; ++q) { const v4u u4 = *(const LAS v4u*)(KT + lane * 72 + 8 * q);
#pragma unroll
          for (int e = 0; e < 4; ++e) { const float lo = bflo(u4[e]), hi = bfhi(u4[e]); ss = fmaf(lo, lo, ss); ss = fmaf(hi, hi, ss); } }
      rn_l = rsqrtf(ss + RMS_EPS); }
    tabg[lane] = gam_l; tabrb[lane] = rn_l * beta_l;
    f32x16 lb[3];
    {   bf16x8 fk[2][4];
#pragma unroll
        for (int blk = 0; blk < 2; ++blk)
#pragma unroll
            for (int ks = 0; ks < 4; ++ks) fk[blk][ks] = *(const LAS bf16x8*)(KT + (r + 32 * blk) * 72 + 8 * hh + 16 * ks);
        LDS_WAIT(); asm volatile("" ::: "memory");
#pragma unroll
        for (int bi = 0; bi < 3; ++bi) { const int mb = (bi + 1) >> 1, nb = bi >> 1;
            f32x16 kk;
#pragma unroll
            for (int q = 0; q < 16; ++q) kk[q] = 0.f;
#pragma unroll
            for (int ks = 0; ks < 4; ++ks) kk = mfma32(fk[mb][ks], fk[nb][ks], kk);
            const float cj_rn = bperm(rn_l, r + 32 * nb), cj_g = bperm(gam_l, r + 32 * nb); const int j = r + 32 * nb;
#pragma unroll
            for (int q = 0; q < 16; ++q) { const int i = crow(q, hh) + 32 * mb; const float rb_i = tabrb[i], g_i = tabg[i];
                lb[bi][q] = (j < i) ? kk[q] * rb_i * cj_rn * __expf(g_i - cj_g) : 0.f; } }
    }
    asm volatile("" ::: "memory");
#pragma unroll
    for (int bi = 0; bi < 3; ++bi) { const int mb = (bi + 1) >> 1, nb = bi >> 1;
#pragma unroll
        for (int q = 0; q < 16; ++q) Lm[(crow(q, hh) + 32 * mb) * 64 + r + 32 * nb] = lb[bi][q]; }
    GDN_LSYNC();
    { unsigned k3pk[32]; GBF* KN = (GBF*)(F.ws + WS_GDN_KN) + r0 * 256 + h * 64 + lane;
#pragma unroll
      for (int t2 = 0; t2 < 32; ++t2) { float k3[2];
#pragma unroll
          for (int u = 0; u < 2; ++u) { const int t = 2 * t2 + u; const float rn_t = rl(rn_l, t), g_t = rl(gam_l, t), b_t = rl(beta_l, t);
              const float kn = w[t] * rn_t; *KN = (bf16)f2bf(kn); KN = opq_ptr(KN + 256); k3[u] = kn * __expf(gam_last - g_t); w[t] = kn * b_t * __expf(g_t); }
          k3pk[t2] = pk2(k3[0], k3[1]); }
      v4u* stash = opq_ptr((v4u*)(F.ws + WS_GDN_N + (size_t)gdn_slot(item) * 8192) + lane);
#pragma unroll
      for (int q = 0; q < 8; ++q) { v4u o = {k3pk[4 * q], k3pk[4 * q + 1], k3pk[4 * q + 2], k3pk[4 * q + 3]}; stash[64 * q] = o; } }
    LDS_WAIT(); asm volatile("" ::: "memory");
#define GDN_SOLVE(X) gdn_solve64(X, Lm)
    GDN_LSYNC();
    GDN_SOLVE(w);
    GDN_LSYNC();
    unsigned wpk[32];
#pragma unroll
    for (int t2 = 0; t2 < 32; ++t2) wpk[t2] = pk2(w[2 * t2], w[2 * t2 + 1]);
    { GBF* W = (GBF*)(F.ws + WS_GDN_W) + r0 * 256 + h * 64 + lane;
#pragma unroll
      for (int t = 0; t < 64; ++t) { *W = (bf16)((t & 1) ? (wpk[t >> 1] >> 16) : (wpk[t >> 1] & 0xffffu)); W = opq_ptr(W + 256); } }
#define GDN_K3_RELOAD() unsigned k3pk[32]; { asm volatile("s_waitcnt vmcnt(0)" ::: "memory"); const v4u* stash = opq_ptr((const v4u*)(F.ws + WS_GDN_N + (size_t)gdn_slot(item) * 8192) + lane); \
        _Pragma("unroll") for (int q = 0; q < 8; ++q) { const v4u o = stash[64 * q]; k3pk[4 * q] = o.x; k3pk[4 * q + 1] = o.y; k3pk[4 * q + 2] = o.z; k3pk[4 * q + 3] = o.w; } }
    {   GDN_K3_RELOAD();
        const float egl = __expf(gam_last);
        unsigned char* Mb = opq_ptr(F.ws + WS_GDN_M + (size_t)gdn_slot(item) * 8192 + lane * 16);
#pragma unroll
        for (int mbT = 0; mbT < 2; ++mbT) {
            f32x16 mt[2];
#pragma unroll
            for (int j = 0; j < 2; ++j)
#pragma unroll
                for (int q = 0; q < 16; ++q) mt[j][q] = 0.f;
#pragma unroll
            for (int ks = 0; ks < 4; ++ks) { bf16x8 k3f[2], wf[2]; tok_frags(k3pk, ks, k3f[0], k3f[1]); tok_frags(wpk, ks, wf[0], wf[1]);
#pragma unroll
                for (int y = 0; y < 2; ++y) mt[y] = mfma32(wf[mbT], k3f[y], mt[y]); }
#pragma unroll
            for (int nbT = 0; nbT < 2; ++nbT)
#pragma unroll
                for (int g = 0; g < 4; ++g) { float m4[4];
#pragma unroll
                    for (int k = 0; k < 4; ++k) { const int q = 4 * g + k; m4[k] = -mt[nbT][q] + ((mbT == nbT && crow(q, hh) == r) ? egl : 0.f); }
                    v2u o; o.x = pk2(m4[0], m4[1]); o.y = pk2(m4[2], m4[3]);
                    *(v2u*)(Mb + (((nbT * 2 + mbT) * 2 + (g >> 1)) * 1024 + (g & 1) * 8)) = o; }
            asm volatile("" ::: "memory");
        }
    }
    asm volatile("" ::: "memory");
    unsigned upk[32];
    {   float u[64];
        GDN_LSYNC();
        GDN_CONV_PASS(512, u[t] = val * rl(beta_l, t));
        GDN_LSYNC();
        GDN_SOLVE(u);
        GDN_LSYNC();
#pragma unroll
        for (int t2 = 0; t2 < 32; ++t2) upk[t2] = pk2(u[2 * t2], u[2 * t2 + 1]);
    }
#undef GDN_SOLVE
    { bf16* UT = opq_ptr((bf16*)(F.ws + WS_GDN_UT) + (size_t)item * 4096 + lane * 64);
#pragma unroll
      for (int q = 0; q < 8; ++q) { v4u o = {upk[4 * q], upk[4 * q + 1], upk[4 * q + 2], upk[4 * q + 3]}; *(v4u*)(UT + 8 * q) = o; } }
    {   GDN_K3_RELOAD();
        bf16* Nbase = opq_ptr((bf16*)(F.ws + WS_GDN_N) + (size_t)gdn_slot(item) * 4096 + lane * 4);
        bf16x8 k3fa[4][2];
#pragma unroll
        for (int ks = 0; ks < 4; ++ks) tok_frags(k3pk, ks, k3fa[ks][0], k3fa[ks][1]);
        asm volatile("s_waitcnt vmcnt(0)" ::: "memory");
#pragma unroll
        for (int nb = 0; nb < 2; ++nb) {
            f32x16 nn[2];
#pragma unroll
            for (int j = 0; j < 2; ++j)
#pragma unroll
                for (int q = 0; q < 16; ++q) nn[j][q] = 0.f;
#pragma unroll
            for (int ks = 0; ks < 4; ++ks) { bf16x8 uf[2]; tok_frags(upk, ks, uf[0], uf[1]);
#pragma unroll
                for (int x = 0; x < 2; ++x) nn[x] = mfma32(k3fa[ks][x], uf[nb], nn[x]); }
#pragma unroll
            for (int mb = 0; mb < 2; ++mb)
#pragma unroll
                for (int g = 0; g < 4; ++g) { v2u w2; w2.x = pk2(nn[mb][4 * g], nn[mb][4 * g + 1]); w2.y = pk2(nn[mb][4 * g + 2], nn[mb][4 * g + 3]);
                    *(v2u*)(Nbase + ((nb * 2 + mb) * 4 + g) * 256) = w2; }
            asm volatile("" ::: "memory");
        }
    }
}
#define GAS __attribute__((address_space(1)))
__device__ __forceinline__ void gdn_scan_wave(Frame& F, int bh, int nb) {
    const int lane = F.lane;
    const unsigned char* Mg = F.ws + WS_GDN_M + (size_t)bh * 128 * 8192 + lane * 16;
    unsigned char* Ng = F.ws + WS_GDN_N + (size_t)bh * 128 * 8192 + nb * 4096;
    LAS unsigned char* ring = F.lds;
    constexpr int SLOT = 12288;
#define GDN_SCAN_ISSUE(cc) do { const int c_ = (cc) < 128 ? (cc) : 127; const int so_ = ((cc) & 7) * SLOT; \
        _Pragma("unroll") for (int f = 0; f < 8; ++f) __builtin_amdgcn_global_load_lds((const unsigned*)(Mg + (size_t)c_ * 8192 + f * 1024), (LAS unsigned*)(ring + so_ + f * 1024), 16, 0, 0); \
        _Pragma("unroll") for (int i = 0; i < 4; ++i) __builtin_amdgcn_global_load_lds((const unsigned*)(Ng + (size_t)c_ * 8192 + i * 1024 + lane * 16), (LAS unsigned*)(ring + so_ + 8192 + i * 1024), 16, 0, 0); } while (0)
    f32x16 acc[2];
#pragma unroll
    for (int i = 0; i < 2; ++i)
#pragma unroll
        for (int q = 0; q < 16; ++q) acc[i][q] = 0.f;
    GDN_SCAN_ISSUE(0); GDN_SCAN_ISSUE(1); GDN_SCAN_ISSUE(2); GDN_SCAN_ISSUE(3); GDN_SCAN_ISSUE(4); GDN_SCAN_ISSUE(5);
    for (int c = 0; c < 128; ++c) {
        const int so = (c & 7) * SLOT;
        asm volatile("s_waitcnt vmcnt(60)" ::: "memory");
        bf16x8 mf[2][2][2]; v2u nr[2][4];
#pragma unroll
        for (int mb = 0; mb < 2; ++mb) {
#pragma unroll
            for (int kb = 0; kb < 2; ++kb)
#pragma unroll
                for (int s = 0; s < 2; ++s) mf[mb][kb][s] = *(const LAS bf16x8*)(ring + so + ((mb * 2 + kb) * 2 + s) * 1024 + lane * 16);
#pragma unroll
            for (int g = 0; g < 4; ++g) nr[mb][g] = *(const LAS v2u*)(ring + so + 8192 + (mb * 4 + g) * 512 + lane * 8); }
        asm volatile("s_waitcnt lgkmcnt(0)" ::: "memory");
        __builtin_amdgcn_sched_barrier(0);
        GDN_SCAN_ISSUE(c + 6);
        bf16x8 sfr[2][2];
#pragma unroll
        for (int kb = 0; kb < 2; ++kb)
#pragma unroll
            for (int s = 0; s < 2; ++s) sfr[kb][s] = acc_frag(acc[kb], s);
#pragma unroll
        for (int mb = 0; mb < 2; ++mb)
#pragma unroll
            for (int g = 0; g < 4; ++g) { v2u o; o.x = pk2(acc[mb][4 * g], acc[mb][4 * g + 1]); o.y = pk2(acc[mb][4 * g + 2], acc[mb][4 * g + 3]);
                *(GAS v2u*)(Ng + (size_t)c * 8192 + (mb * 4 + g) * 512 + lane * 8) = o; }
#pragma unroll
        for (int mb = 0; mb < 2; ++mb) { f32x16 t;
#pragma unroll
            for (int g = 0; g < 4; ++g) { t[4 * g] = bflo(nr[mb][g].x); t[4 * g + 1] = bfhi(nr[mb][g].x); t[4 * g + 2] = bflo(nr[mb][g].y); t[4 * g + 3] = bfhi(nr[mb][g].y); }
#pragma unroll
            for (int kb = 0; kb < 2; ++kb)
#pragma unroll
                for (int s = 0; s < 2; ++s) t = mfma32(mf[mb][kb][s], sfr[kb][s], t);
            acc[mb] = t; }
    }
    asm volatile("s_waitcnt vmcnt(0)" ::: "memory");
#undef GDN_SCAN_ISSUE
}
__device__ __forceinline__ void gdn_c_item(Frame& F, const Args& a, int l, int item) {
    const int c = item & 127, bh = item >> 7, h = bh & 3, b = bh >> 2; int lane_ = F.lane; asm volatile("" : "+v"(lane_)); const int lane = lane_, r = lane & 31, hh = lane >> 5;
    const size_t r0 = (size_t)b * SEQ + (size_t)c * 64;
    const bf16* QC = (const bf16*)(F.ws + WS_GDN_QC) + r0 * 256 + h * 64; const bf16* KN = (const bf16*)(F.ws + WS_GDN_KN) + r0 * 256 + h * 64; const bf16* W = (const bf16*)(F.ws + WS_GDN_W) + r0 * 256 + h * 64;
    const bf16* UT = (const bf16*)(F.ws + WS_GDN_UT) + (size_t)item * 4096; const bf16* Sb = (const bf16*)(F.ws + WS_GDN_N) + (size_t)gdn_slot(item) * 4096;
    const float* GB = (const float*)(F.ws + WS_GDN_GB) + r0 * 8;
    const float gam_l = GB[lane * 8 + h];
    float gi[2], rnq[2];
    bf16x8 qf[2][2][2];
#pragma unroll
    for (int ib = 0; ib < 2; ++ib) { gi[ib] = GB[(r + 32 * ib) * 8 + h]; float ss = 0.f;
#pragma unroll
        for (int mb = 0; mb < 2; ++mb)
#pragma unroll
            for (int s = 0; s < 2; ++s) { qf[ib][mb][s] = load_row_frag(QC + (size_t)(r + 32 * ib) * 256 + 32 * mb + 16 * s + 4 * hh);
                const v4u qq = __builtin_bit_cast(v4u, qf[ib][mb][s]);
#pragma unroll
                for (int e = 0; e < 4; ++e) { const float lo = bflo(qq[e]), hi = bfhi(qq[e]); ss = fmaf(lo, lo, ss); ss = fmaf(hi, hi, ss); } }
        ss += bperm(ss, lane ^ 32); rnq[ib] = rsqrtf(ss + RMS_EPS) * 0.125f; }
    f32x16 pt[2][2], ot[2][2];
#pragma unroll
    for (int i = 0; i < 2; ++i)
#pragma unroll
        for (int j = 0; j < 2; ++j)
#pragma unroll
            for (int q = 0; q < 16; ++q) { pt[i][j][q] = 0.f; ot[i][j][q] = 0.f; }
#pragma unroll
    for (int jb = 0; jb < 2; ++jb)
#pragma unroll
        for (int mb = 0; mb < 2; ++mb)
#pragma unroll
            for (int s = 0; s < 2; ++s) { const bf16x8 kf = load_row_frag(KN + (size_t)(r + 32 * jb) * 256 + 32 * mb + 16 * s + 4 * hh);
#pragma unroll
                for (int ib = jb; ib < 2; ++ib) pt[jb][ib] = mfma32(kf, qf[ib][mb][s], pt[jb][ib]); }
#pragma unroll
    for (int jb = 0; jb < 2; ++jb)
#pragma unroll
        for (int q = 0; q < 16; ++q) { const int jl = crow(q, hh); const float gj = bperm(gam_l, jl + 32 * jb);
#pragma unroll
            for (int ib = jb; ib < 2; ++ib) { const bool keep = (ib > jb) || (jl <= r); pt[jb][ib][q] = keep ? pt[jb][ib][q] * rnq[ib] * __expf(gi[ib] - gj) : 0.f; } }
    {   bf16x8 sf[2][2][2];
#pragma unroll
        for (int eb = 0; eb < 2; ++eb)
#pragma unroll
            for (int mb = 0; mb < 2; ++mb)
#pragma unroll
                for (int s = 0; s < 2; ++s) sf[eb][mb][s] = load_acc_frag(Sb, eb, mb, s, lane);
#pragma unroll
        for (int eb = 0; eb < 2; ++eb)
#pragma unroll
            for (int mb = 0; mb < 2; ++mb)
#pragma unroll
                for (int s = 0; s < 2; ++s)
#pragma unroll
                    for (int ib = 0; ib < 2; ++ib) ot[eb][ib] = mfma32(sf[eb][mb][s], qf[ib][mb][s], ot[eb][ib]);
#pragma unroll
        for (int ib = 0; ib < 2; ++ib) { const float sc = rnq[ib] * __expf(gi[ib]);
#pragma unroll
            for (int eb = 0; eb < 2; ++eb)
#pragma unroll
                for (int q = 0; q < 16; ++q) ot[eb][ib][q] *= sc; }
#pragma unroll
        for (int jb = 0; jb < 2; ++jb) {
            f32x16 vn[2];
#pragma unroll
            for (int eb = 0; eb < 2; ++eb)
#pragma unroll
                for (int q = 0; q < 16; ++q) vn[eb][q] = 0.f;
#pragma unroll
            for (int mb = 0; mb < 2; ++mb)
#pragma unroll
                for (int s = 0; s < 2; ++s) { const bf16x8 wf = load_row_frag(W + (size_t)(r + 32 * jb) * 256 + 32 * mb + 16 * s + 4 * hh);
#pragma unroll
                    for (int eb = 0; eb < 2; ++eb) vn[eb] = mfma32(wf, sf[eb][mb][s], vn[eb]); }
#pragma unroll
            for (int eb = 0; eb < 2; ++eb)
#pragma unroll
                for (int g = 0; g < 4; ++g) { const v2u uu = *(const v2u*)(UT + (size_t)(r + 32 * eb) * 64 + 32 * jb + 8 * g + 4 * hh);
                    vn[eb][4 * g] = bflo(uu.x) - vn[eb][4 * g]; vn[eb][4 * g + 1] = bfhi(uu.x) - vn[eb][4 * g + 1];
                    vn[eb][4 * g + 2] = bflo(uu.y) - vn[eb][4 * g + 2]; vn[eb][4 * g + 3] = bfhi(uu.y) - vn[eb][4 * g + 3]; }
#pragma unroll
            for (int s = 0; s < 2; ++s) { bf16x8 vf[2];
#pragma unroll
                for (int eb = 0; eb < 2; ++eb) vf[eb] = acc_frag(vn[eb], s);
#pragma unroll
                for (int ib = jb; ib < 2; ++ib) { const bf16x8 pf = acc_frag(pt[jb][ib], s);
#pragma unroll
                    for (int eb = 0; eb < 2; ++eb) ot[eb][ib] = mfma32(vf[eb], pf, ot[eb][ib]); } }
        }
    }
    const float* nw = a.in[13] + l * 64; bf16* MIXp = (bf16*)(F.ws + WS_MIX); const bf16* PZ = (const bf16*)(F.ws + WS_PROJ) + r0 * PROJW + PC_DZ + h * 64;
#pragma unroll
    for (int ib = 0; ib < 2; ++ib) { float ss = 0.f;
#pragma unroll
        for (int eb = 0; eb < 2; ++eb)
#pragma unroll
            for (int q = 0; q < 16; ++q) ss = fmaf(ot[eb][ib][q], ot[eb][ib][q], ss);
        ss += bperm(ss, lane ^ 32); const float rs = rsqrtf(ss * (1.f / 64.f) + RMS_EPS);
        const size_t row = r0 + r + 32 * ib;
#pragma unroll
        for (int eb = 0; eb < 2; ++eb) { v2u pkd[4];
#pragma unroll
            for (int g = 0; g < 4; ++g) { const int e0 = 32 * eb + 8 * g + 4 * hh;
                const v2u zz = *(const v2u*)(PZ + (size_t)(r + 32 * ib) * PROJW + e0); const f32x4 w4 = *(const f32x4*)(nw + e0);
                const float y0 = ot[eb][ib][4 * g] * rs * w4.x * siluf(bflo(zz.x)), y1 = ot[eb][ib][4 * g + 1] * rs * w4.y * siluf(bfhi(zz.x));
                const float y2 = ot[eb][ib][4 * g + 2] * rs * w4.z * siluf(bflo(zz.y)), y3 = ot[eb][ib][4 * g + 3] * rs * w4.w * siluf(bfhi(zz.y));
                pkd[g].x = pk2(y0, y1); pkd[g].y = pk2(y2, y3); }
            store_row32_wide(MIXp + row * DM + 256 + h * 64 + 32 * eb, pkd, hh); }
    }
}
constexpr size_t WS_SEL = 500 * MiB;
constexpr size_t WS_PART1 = 468 * MiB;
constexpr size_t WS_LP = 502 * MiB;
constexpr size_t WS_END3 = 506 * MiB;
constexpr float MOBA_C = 0.125f * 1.4426950408889634f;
constexpr int KL_STRIDE = 72, VL_STRIDE = 72;
constexpr int MOBA_KL_OFF = 0, MOBA_VL_OFF = 256 * 72 * 2, MOBA_LIST_OFF = MOBA_VL_OFF + 256 * 72 * 2, MOBA_MISC_OFF = MOBA_LIST_OFF + 8192 * 2;

__device__ __forceinline__ void moba_gate_wg(Frame& F, int item) {
    const int grp = item & 15, bh = item >> 4, h = bh & 7, b = bh >> 3; const int lane = F.lane;
    LAS float* kml = (LAS float*)F.lds;
    { const f32x4* km = (const f32x4*)((const float*)(F.ws + WS_KMEAN) + (size_t)F.layer * 65536 + (size_t)bh * 32 * 64) + F.tid; *(LAS f32x4*)(kml + 4 * F.tid) = *km; }
    const int qb = grp * 8 + F.wave; const int t = qb * 64 + lane, own = (qb * 64) >> 8;
    const bf16* qp = (const bf16*)(F.ws + WS_PROJ) + ((size_t)b * SEQ + t) * PROJW + PC_MQ + h * 64;
    float q[64];
#pragma unroll
    for (int c = 0; c < 8; ++c) { const v4u u = ((const v4u*)qp)[c];
#pragma unroll
        for (int e = 0; e < 4; ++e) { q[8 * c + 2 * e] = bflo(u[e]); q[8 * c + 2 * e + 1] = bfhi(u[e]); } }
    __syncthreads();
    float v0 = -INFINITY, v1 = -INFINITY, v2 = -INFINITY; unsigned i0 = 0xFF, i1 = 0xFF, i2 = 0xFF;
    for (int n = 0; n < own; ++n) {
        float s = 0.f;
#pragma unroll
        for (int c = 0; c < 16; ++c) { const f32x4 k4 = *(const LAS f32x4*)(kml + n * 64 + 4 * c);
            s = fmaf(q[4 * c], k4.x, s); s = fmaf(q[4 * c + 1], k4.y, s); s = fmaf(q[4 * c + 2], k4.z, s); s = fmaf(q[4 * c + 3], k4.w, s); }
        if (s > v0) { v2 = v1; i2 = i1; v1 = v0; i1 = i0; v0 = s; i0 = n; }
        else if (s > v1) { v2 = v1; i2 = i1; v1 = s; i1 = n; }
        else if (s > v2) { v2 = s; i2 = n; }
    }
    ((unsigned*)(F.ws + WS_SEL))[(size_t)bh * SEQ + t] = i0 | (i1 << 8) | (i2 << 16);
    __syncthreads();
}
typedef short s16x4 __attribute__((ext_vector_type(4)));
__device__ __forceinline__ s16x4 moba_vtr(const LAS bf16* p) { return __builtin_bit_cast(s16x4, __builtin_amdgcn_ds_read_tr16_b64_v4i16((LAS s16x4*)p)); }
template <bool CAUSAL, int NKB, int NIB>
__device__ __forceinline__ void moba_tile(const LAS bf16* KL, const LAS bf16* VL, const bf16* q0p, const bf16* q1p, float kmaxc, int nkb, int pos0, int pos1, int lane, f32x16 (&ot)[2][2], float (&lsum)[2]) {
    const int r = lane & 31, hh = lane >> 5;
    bf16x8 qf[2][4]; float mref[2];
#pragma unroll
    for (int ib = 0; ib < NIB; ++ib) { const bf16* qp = ib ? q1p : q0p; float ss = 0.f;
#pragma unroll
        for (int ks = 0; ks < 4; ++ks) { const v4u u = *(const v4u*)(qp + 8 * hh + 16 * ks); qf[ib][ks] = __builtin_bit_cast(bf16x8, u);
#pragma unroll
            for (int e = 0; e < 4; ++e) { const float lo = bflo(u[e]), hi = bfhi(u[e]); ss = fmaf(lo, lo, ss); ss = fmaf(hi, hi, ss); } }
        ss += bperm(ss, lane ^ 32); mref[ib] = sqrtf(ss) * kmaxc; lsum[ib] = 0.f; }
#pragma unroll
    for (int i = 0; i < 2; ++i)
#pragma unroll
        for (int j = 0; j < 2; ++j)
#pragma unroll
            for (int q = 0; q < 16; ++q) ot[i][j][q] = 0.f;
#define MOBA_KB_BODY(jb) {         f32x16 st[2]; \
_Pragma("unroll") \
        for (int ib = 0; ib < NIB; ++ib) \
_Pragma("unroll") \
            for (int q = 0; q < 16; ++q) st[ib][q] = 0.f; \
_Pragma("unroll") \
        for (int ks = 0; ks < 4; ++ks) { const bf16x8 kf = *(const LAS bf16x8*)(KL + (32 * jb + r) * KL_STRIDE + 8 * hh + 16 * ks); \
            st[0] = mfma32(kf, qf[0][ks], st[0]); if (NIB > 1) st[1] = mfma32(kf, qf[1][ks], st[1]); } \
_Pragma("unroll") \
        for (int ib = 0; ib < NIB; ++ib) { const int pos = ib ? pos1 : pos0; float ls = 0.f; \
_Pragma("unroll") \
            for (int q = 0; q < 16; ++q) { float p = __builtin_amdgcn_exp2f(fmaf(st[ib][q], MOBA_C, -mref[ib])); \
                if (CAUSAL) { if (32 * jb + crow(q, hh) > pos) p = 0.f; } \
                st[ib][q] = p; ls += p; } \
            lsum[ib] += ls; } \
_Pragma("unroll") \
        for (int s = 0; s < 2; ++s) { const bf16x8 pf0 = acc_frag(st[0], s), pf1 = acc_frag(st[NIB - 1], s); \
_Pragma("unroll") \
            for (int eb = 0; eb < 2; ++eb) { const LAS bf16* vp = VL + (32 * jb + 16 * s + 4 * hh + ((lane >> 2) & 3)) * VL_STRIDE + 32 * eb + 16 * ((lane >> 4) & 1) + 4 * (lane & 3); \
                const s16x4 lo = moba_vtr(vp), hi = moba_vtr(vp + 8 * VL_STRIDE); const bf16x8 vf = (bf16x8){lo[0], lo[1], lo[2], lo[3], hi[0], hi[1], hi[2], hi[3]}; \
                ot[eb][0] = mfma32(vf, pf0, ot[eb][0]); if (NIB > 1) ot[eb][1] = mfma32(vf, pf1, ot[eb][1]); } } \
     }
    if constexpr (NKB > 0) {
#pragma unroll
        for (int jb = 0; jb < NKB; ++jb) MOBA_KB_BODY(jb)
    } else {
#pragma nounroll
        for (int jb = 0; jb < nkb; ++jb) MOBA_KB_BODY(jb)
    }
#undef MOBA_KB_BODY
#pragma unroll
    for (int ib = 0; ib < NIB; ++ib) lsum[ib] += bperm(lsum[ib], lane ^ 32);
}
__device__ __forceinline__ void moba_load_kv(Frame& F, int b, int h, int n) {
    const bf16* PROJ = (const bf16*)(F.ws + WS_PROJ);
    LAS bf16* KL = (LAS bf16*)(F.lds + MOBA_KL_OFF); LAS bf16* VL = (LAS bf16*)(F.lds + MOBA_VL_OFF);
#pragma unroll
    for (int c = 0; c < 4; ++c) { const int ch = F.tid + 512 * c; const int row = ch >> 3, part = ch & 7;
        const v4u u = *(const v4u*)(PROJ + ((size_t)b * SEQ + n * 256 + row) * PROJW + PC_MK + h * 64 + part * 8); *(LAS v4u*)(KL + row * KL_STRIDE + part * 8) = u; }
#pragma unroll
    for (int c = 0; c < 4; ++c) { const int ch = F.tid + 512 * c; const int row = ch >> 3, part = ch & 7;
        const v4u u = *(const v4u*)(PROJ + ((size_t)b * SEQ + n * 256 + row) * PROJW + PC_MV + h * 64 + part * 8); *(LAS v4u*)(VL + row * VL_STRIDE + part * 8) = u; }
}
__device__ __forceinline__ float moba_kmaxc(Frame& F, int b, int h) {
    const unsigned* km = (const unsigned*)(F.ws + WS_KMAXH) + F.layer * 64 + (b * 8 + h) * 2; return sqrtf(__uint_as_float(km[0]) + __uint_as_float(km[1])) * MOBA_C;
}
__device__ __forceinline__ bf16* moba_part_ptr(Frame& F, int slot, size_t row, int h) {
    const size_t o0 = WS_MIX + (row * DM + 512 + h * 64) * 2, o1 = WS_PART1 + (row * 8 + h) * 128, o2 = WS_PROJ + (row * PROJW + PC_DQ + h * 64) * 2;
    return (bf16*)(F.ws + (slot == 0 ? o0 : slot == 1 ? o1 : o2)); }
__device__ __forceinline__ void moba_pd_item(Frame& F, int b, int h, int n) {
    LAS bf16* KL = (LAS bf16*)(F.lds + MOBA_KL_OFF); LAS bf16* VL = (LAS bf16*)(F.lds + MOBA_VL_OFF);
    LAS unsigned short* list = (LAS unsigned short*)(F.lds + MOBA_LIST_OFF); LAS unsigned* misc = (LAS unsigned*)(F.lds + MOBA_MISC_OFF);
    const int lane = F.lane, r = lane & 31, hh = lane >> 5;
    moba_load_kv(F, b, h, n);
    const unsigned* SEL = (const unsigned*)(F.ws + WS_SEL) + (size_t)(b * 8 + h) * SEQ;
    const int tq0 = (n + 1) * 256, per = (SEQ - tq0) >> 3;
    const int ws0 = tq0 + F.wave * per;
    unsigned sv[16];
#pragma unroll
    for (int i = 0; i < 16; ++i) { const int t = ws0 + 64 * i + lane; sv[i] = (64 * i + lane < per) ? SEL[t] : 0xFFFFFFFFu; }
    int slotv[16]; int cnt = 0;
#pragma unroll
    for (int i = 0; i < 16; ++i) { const unsigned s = sv[i];
        slotv[i] = ((s & 0xFF) == (unsigned)n) ? 0 : (((s >> 8) & 0xFF) == (unsigned)n) ? 1 : (((s >> 16) & 0xFF) == (unsigned)n) ? 2 : -1;
        cnt += __popcll(__ballot(slotv[i] >= 0)); }
    if (lane == 0) misc[F.wave] = (unsigned)cnt;
    __syncthreads();
    int off = 0, total = 0;
#pragma unroll
    for (int w = 0; w < 8; ++w) { const int c = (int)misc[w]; if (w < F.wave) off += c; total += c; }
#pragma unroll
    for (int i = 0; i < 16; ++i) { const unsigned long long bal = __ballot(slotv[i] >= 0); const int pre = __popcll(bal & ((1ull << lane) - 1ull));
        if (slotv[i] >= 0) list[off + pre] = (unsigned short)((ws0 + 64 * i + lane) | (slotv[i] << 13));
        off += __popcll(bal); }
    const float kmaxc = moba_kmaxc(F, b, h);
    __syncthreads();
    const bf16* PROJ = (const bf16*)(F.ws + WS_PROJ); float* LP = (float*)(F.ws + WS_LP);
    for (int tile = F.wave; tile * 64 < total; tile += 8) {
        int idx[2], tq[2], slot[2]; size_t row[2];
#pragma unroll
        for (int ib = 0; ib < 2; ++ib) { idx[ib] = tile * 64 + 32 * ib + r; const int ii = idx[ib] < total ? idx[ib] : total - 1; const unsigned e = list[ii]; tq[ib] = e & 0x1fff; slot[ib] = e >> 13; row[ib] = (size_t)b * SEQ + tq[ib]; }
        f32x16 ot[2][2]; float lsum[2];
        moba_tile<false, 8, 2>(KL, VL, PROJ + row[0] * PROJW + PC_MQ + h * 64, PROJ + row[1] * PROJW + PC_MQ + h * 64, kmaxc, 8, 0, 0, lane, ot, lsum);
#pragma unroll
        for (int ib = 0; ib < 2; ++ib) if (idx[ib] < total) {
            bf16* pp = moba_part_ptr(F, slot[ib], row[ib], h) + 32 * hh;
#pragma unroll
            for (int j = 0; j < 4; ++j) { const int eb = j >> 1, g = 2 * (j & 1); v4u w;
                w.x = pk2(ot[eb][ib][4 * g], ot[eb][ib][4 * g + 1]); w.y = pk2(ot[eb][ib][4 * g + 2], ot[eb][ib][4 * g + 3]);
                w.z = pk2(ot[eb][ib][4 * g + 4], ot[eb][ib][4 * g + 5]); w.w = pk2(ot[eb][ib][4 * g + 6], ot[eb][ib][4 * g + 7]); ((v4u*)pp)[j] = w; }
            if (hh == 0) LP[(row[ib] * 8 + h) * 4 + slot[ib]] = lsum[ib]; }
    }
    __syncthreads();
}
__device__ __forceinline__ void moba_pe_item(Frame& F, int b, int h, int o) {
    LAS bf16* KL = (LAS bf16*)(F.lds + MOBA_KL_OFF); LAS bf16* VL = (LAS bf16*)(F.lds + MOBA_VL_OFF);
    const int lane = F.lane, r = lane & 31, hh = lane >> 5;
    moba_load_kv(F, b, h, o);
    const float kmaxc = moba_kmaxc(F, b, h);
    __syncthreads();
    {
        const int t = F.wave; const bf16* PROJ = (const bf16*)(F.ws + WS_PROJ); const float* LP = (const float*)(F.ws + WS_LP); bf16* MIXp = (bf16*)(F.ws + WS_MIX);
        const int pos = 32 * t + r; const size_t row = (size_t)b * SEQ + o * 256 + pos;
        f32x16 ot[2][2]; float lsum[2];
        moba_tile<true, 0, 1>(KL, VL, PROJ + row * PROJW + PC_MQ + h * 64, PROJ + row * PROJW + PC_MQ + h * 64, kmaxc, t + 1, pos, pos, lane, ot, lsum);
        const int nsel = o < 3 ? o : 3;
        float l = lsum[0];
        for (int s = 0; s < nsel; ++s) { l += LP[(row * 8 + h) * 4 + s]; const bf16* pp = moba_part_ptr(F, s, row, h) + 32 * hh;
#pragma unroll
            for (int j = 0; j < 4; ++j) { const int eb = j >> 1, g = 2 * (j & 1); const v4u w = ((const v4u*)pp)[j];
                ot[eb][0][4 * g] += bflo(w.x); ot[eb][0][4 * g + 1] += bfhi(w.x); ot[eb][0][4 * g + 2] += bflo(w.y); ot[eb][0][4 * g + 3] += bfhi(w.y);
                ot[eb][0][4 * g + 4] += bflo(w.z); ot[eb][0][4 * g + 5] += bfhi(w.z); ot[eb][0][4 * g + 6] += bflo(w.w); ot[eb][0][4 * g + 7] += bfhi(w.w); } }
        const float il = 1.f / l;
#pragma unroll
        for (int eb = 0; eb < 2; ++eb) { v2u pkd[4];
#pragma unroll
            for (int g = 0; g < 4; ++g) { pkd[g].x = pk2(ot[eb][0][4 * g] * il, ot[eb][0][4 * g + 1] * il); pkd[g].y = pk2(ot[eb][0][4 * g + 2] * il, ot[eb][0][4 * g + 3] * il); }
            store_row32_wide(MIXp + row * DM + 512 + h * 64 + 32 * eb, pkd, hh); }
    }
    __syncthreads();
}
__global__ void __launch_bounds__(NTHREADS, 2) mk_fwd(Args args) {
    extern __shared__ __attribute__((aligned(16))) unsigned char lds[];
    cg::grid_group grid = cg::this_grid();
    Frame F; F.lds = (LAS unsigned char*)lds; F.ldsg = lds; F.tid = threadIdx.x; F.lane = F.tid & 63; F.wave = __builtin_amdgcn_readfirstlane(F.tid >> 6);
    F.G = gridDim.x; F.wave_s = __builtin_amdgcn_readfirstlane((int)(threadIdx.x >> 6)); refresh(F, args);
#define XB ((bf16*)(F.ws + WS_XB))
#define PROJ ((bf16*)(F.ws + WS_PROJ))
#define MIX ((bf16*)(F.ws + WS_MIX))
#define RSTD ((float*)(F.ws + WS_RSTD))
#define SMALL ((float*)(F.ws + WS_SMALL))
#define GRID_BAR() do { xcd_barrier(bar); refresh(F, args); } while (0)
    volatile LAS unsigned* MISC = (volatile LAS unsigned*)(F.lds + LDS_BYTES - 64);
    if (F.tid < 16) MISC[F.tid] = 0u;
    __syncthreads();
    { unsigned* ctl = (unsigned*)(F.ws + WS_CTL);
      for (int i = F.bid * NTHREADS + F.tid; i < (int)(CTL_ZERO_BYTES / 4); i += F.G * NTHREADS) __hip_atomic_store(ctl + i, 0u, __ATOMIC_RELAXED, __HIP_MEMORY_SCOPE_AGENT);
      __threadfence(); }
    p0_weights(F, args, 0, 0, F.wave * F.G + F.bid, F.G * NWAVES, 0, W_ITEMS_EARLY);     p0_table(F); p0_xb(F, args.in[0], (bf16*)args.out);
    __syncthreads(); grid.sync(); refresh(F, args);
    XcdBarrier bar = xcd_barrier_post((unsigned*)(F.ws + WS_CTL) + 4096, MISC + 8);

    for (int l_ = 0; l_ < DEPTH; ++l_) {
        int l = l_; asm volatile("" : "+s"(l)); F.layer = l;
#define WL(off) ((const bf16*)(F.ws + WS_W + (size_t)l * W_LAYER + (off)))
#define Win WL(W_IN_OFF)
#define Wo WL(W_O_OFF)
#define Wgu WL(W_GU_OFF)
#define Wd WL(W_D_OFF)
        bf16* const RB = (bf16*)args.out;
        bf16* const RB2 = (l == DEPTH - 1) ? MIX : RB;
        { pg8::Gemm g{RB, Win, MTOK, PROJW, DM}; pg8::StaticOrder S; S.init(MTOK, PROJW, F.G, F.bid); pg8::EpiInProj E{PROJ, SMALL, RSTD, (const float*)(F.ws + WS_TAB), (float*)(F.ws + WS_KMEAN) + (size_t)l * 65536, (unsigned*)(F.ws + WS_KMAXH) + l * 64};
          pg8::gemm_phase<pg8::EpiInProj, pg8::StaticOrder, true, true>(F.lds, g, S, E, F.tid); }
        for (int tile = F.bid * NWAVES + F.wave; tile < MTOK / 16; tile += F.G * NWAVES) small_proj_tile(F, RB, Win, RSTD, tile);
        GRID_BAR();
        for (int it = F.bid * NWAVES + F.wave; it < 2048; it += F.G * NWAVES) { gla_a_warm(F, it); gdn_a_warm(F, it); gla_a_item(F, args, l, it); __builtin_amdgcn_s_barrier(); gdn_a_item(F, args, l, it); }
        __syncthreads();
        for (int it = F.bid; it < 512; it += F.G) moba_gate_wg(F, (it < 256) ? it : 767 - it);
        GRID_BAR();
        if (F.bid < 32) {
            if (F.wave == 0) gdn_scan_wave(F, F.bid >> 1, F.bid & 1);
            else { for (int gi = F.bid * 448 + (F.tid - 64); gi < 16384; gi += 32 * 448) gla_scan(F, gi); } }
        else p0_weights(F, args, 1, l, (F.bid - 32) * NWAVES + F.wave, (F.G - 32) * NWAVES, l == 0 ? 0 : W_ITEMS_EARLY, W_ITEMS_ALL);
        __syncthreads();
        { volatile LAS unsigned* qslot = (volatile LAS unsigned*)(F.lds + LDS_BYTES - 64) + 4;
          for (;;) { if (F.tid == 0) qslot[0] = __hip_atomic_fetch_add((unsigned*)(F.ws + WS_CTL) + 24 + l, 1u, __ATOMIC_RELAXED, __HIP_MEMORY_SCOPE_AGENT);
              __syncthreads(); const unsigned q = qslot[0]; __syncthreads();
              if (q >= 992u) break;
              const int n = (int)(q >> 5), bh = (int)(q & 31u); moba_pd_item(F, bh >> 3, bh & 7, n); } }
        GRID_BAR();
        for (int it = F.bid * NWAVES + F.wave; it < 2048; it += F.G * NWAVES) { gla_c_item(F, args, l, it); __builtin_amdgcn_s_barrier(); gdn_c_item(F, args, l, it); }
        __syncthreads();
        for (int it = F.bid; it < 1024; it += F.G) moba_pe_item(F, (it & 31) >> 3, it & 7, it >> 5);
        GRID_BAR();
        { pg8::Gemm g{MIX, Wo, MTOK, DM, DM}; pg8::StaticOrder S; S.init(MTOK, DM, F.G, F.bid); pg8::EpiPlainBf16 E{XB, DM};
          pg8::gemm_phase<pg8::EpiPlainBf16, pg8::StaticOrder, true, true>(F.lds, g, S, E, F.tid); }
        GRID_BAR();
        norm_pass(F, RB, RB2, nullptr, args.in[2] + l * DM, false);
        GRID_BAR();
        { pg8::Gemm g{RB2, Wgu, MTOK, 2 * DFF, DM}; pg8::StaticOrder S; S.init(MTOK, 2 * DFF, F.G, F.bid); pg8::EpiSwiglu E{PROJ, RSTD};
          pg8::gemm_phase<pg8::EpiSwiglu, pg8::StaticOrder, true, true>(F.lds, g, S, E, F.tid); }
        GRID_BAR();
        { pg8::Gemm g{PROJ, Wd, MTOK, DM, DFF}; pg8::StaticOrder S; S.init(MTOK, DM, F.G, F.bid); pg8::EpiPlainBf16 E{XB, DM};
          pg8::gemm_phase<pg8::EpiPlainBf16, pg8::StaticOrder, true, true>(F.lds, g, S, E, F.tid); }
        GRID_BAR();
        norm_pass(F, RB2, RB2, args.out, args.in[4] + l * DM, l == DEPTH - 1);
        if (l_ + 1 < DEPTH) GRID_BAR();
    }
}

extern "C" void kernel_launch(void* const* d_in, const int* in_sizes, int n_in, void* d_out, int out_size, void* d_ws, size_t ws_size, hipStream_t stream) {
    static int grid = 0;
    if (grid == 0) {
        if (n_in != 17 || in_sizes[0] != MTOK * DM || out_size != MTOK * DM || ws_size < WS_END3) { fprintf(stderr, "kernel_launch: unexpected shapes / workspace (n_in %d, ws %zu < %zu)\n", n_in, ws_size, (size_t)WS_END3); grid = -1; return; }
        int dev = 0, cus = 0, per_cu = 0;
        if (hipGetDevice(&dev) != hipSuccess || hipDeviceGetAttribute(&cus, hipDeviceAttributeMultiprocessorCount, dev) != hipSuccess) { grid = -1; return; }
        if (hipFuncSetAttribute((const void*)mk_fwd, hipFuncAttributeMaxDynamicSharedMemorySize, LDS_BYTES) != hipSuccess) { fprintf(stderr, "kernel_launch: hipFuncSetAttribute failed\n"); grid = -1; return; }
        if (hipOccupancyMaxActiveBlocksPerMultiprocessor(&per_cu, (const void*)mk_fwd, NTHREADS, LDS_BYTES) != hipSuccess || per_cu < 1) { fprintf(stderr, "kernel_launch: occupancy query says %d\n", per_cu); (void)hipGetLastError(); grid = -1; return; }
        grid = cus;
    }
    if (grid < 0) return;
    Args a{};
    for (int i = 0; i < 17; ++i) a.in[i] = (const float*)d_in[i];
    a.out = (float*)d_out; a.ws = (unsigned char*)d_ws;
    void* kargs[] = {&a};
    hipError_t e = hipLaunchCooperativeKernel((const void*)mk_fwd, dim3(grid), dim3(NTHREADS), kargs, LDS_BYTES, stream);
    if (e != hipSuccess) fprintf(stderr, "kernel_launch: cooperative launch failed: %s (grid %d)\n", hipGetErrorString(e), grid);
}
```

```cpp
#include <hip/hip_runtime.h>
#include <hip/hip_cooperative_groups.h>
#include <cstdio>
#include <cstdint>
#include <cmath>
namespace pg8 {
#define PG8_LAS __attribute__((address_space(3)))
typedef unsigned short bf16_t;
typedef short bf16x8 __attribute__((ext_vector_type(8)));
typedef float f32x4 __attribute__((ext_vector_type(4)));
typedef unsigned u32x4 __attribute__((ext_vector_type(4)));
constexpr int BM = 256, BK = 64, HALF = 128, HTB = HALF * BK * 2  , STAGE_BYTES = 8 * HTB, NXCD = 8, WGM = 8;

__host__ __device__ __forceinline__ int lds_byte(int r, int c) { const int st = (r >> 4) * 2 + (c >> 5), rr = r & 15, cc = c & 31, ob = rr * 64 + cc * 2; return st * 1024 + (ob ^ (((ob >> 9) & 1) << 5)); }
__host__ __device__ __forceinline__ void stage_rc(int b, int& R, int& C) { const int st = b / 1024, sb = b % 1024, swz = sb ^ (((sb >> 9) & 1) << 5); R = (st >> 1) * 16 + swz / 64; C = (st & 1) * 32 + (swz % 64) / 2; }
__host__ __device__ __forceinline__ int perm32(int rho) { const int n = rho >> 4, i = rho & 15; return 8 * (i >> 2) + 4 * n + (i & 3); }

struct Unit { int pm, pn; };
struct Gemm { const bf16_t* A; const bf16_t* Bt; int M, N, K; };

struct StaticOrder {
    int nM, nN, nwg, G, c;
    __host__ __device__ void init(int M, int N, int G_, int c_) { nM = M / BM; nN = N / BM; nwg = nM * nN; G = G_; c = c_; }
    __host__ __device__ bool next(int i, Unit& u) const {
        const long L = (long)i * G + c; if (L >= nwg) return false;
        int wgid = (int)L; { const int q = nwg / NXCD, r = nwg % NXCD, xcd = wgid % NXCD, off = wgid / NXCD; wgid = (xcd < r ? xcd * (q + 1) : r * (q + 1) + (xcd - r) * q) + off; }
        const int nig = WGM * nN, gid = wgid / nig, fm = gid * WGM, gsz = (nM - fm) < WGM ? (nM - fm) : WGM;
        u.pm = fm + ((wgid % nig) % gsz); u.pn = (wgid % nig) / gsz; return true;
    }
    __device__ __forceinline__ void a_ready(const Unit&) const {}
    __device__ __forceinline__ void done(const Unit&) const {}
};

__device__ __forceinline__ unsigned cvt_pk_bf16(float lo, float hi) { unsigned r; asm volatile("v_cvt_pk_bf16_f32 %0, %1, %2" : "=v"(r) : "v"(lo), "v"(hi)); return r; }
typedef float f32x2 __attribute__((ext_vector_type(2)));
struct EpiPlainBf16 {
    static constexpr bool PERM = true, AFTER_DRAIN = false;
    bf16_t* O; int ldc;
    __device__ __forceinline__ void operator()(const f32x4 (&acc)[2][2][4][2], const Unit& u, int wr, int wc, int fr, int fq) const {
        const int row0 = u.pm * BM + wr * 64 + fr, col0 = u.pn * BM + wc * 32 + 8 * fq;
#pragma unroll
        for (int ai = 0; ai < 2; ++ai)
#pragma unroll
            for (int m = 0; m < 4; ++m) { bf16_t* rowp = O + (size_t)(row0 + ai * HALF + m * 16) * ldc + col0;
#pragma unroll
                for (int bj = 0; bj < 2; ++bj) { const f32x4 v0 = acc[ai][bj][m][0], v1 = acc[ai][bj][m][1];
                    u32x4 w; w.x = cvt_pk_bf16(v0[0], v0[1]); w.y = cvt_pk_bf16(v0[2], v0[3]); w.z = cvt_pk_bf16(v1[0], v1[1]); w.w = cvt_pk_bf16(v1[2], v1[3]);
                    *(u32x4*)(rowp + bj * HALF) = w; } }
    }
};
struct EpiInProj {
    static constexpr bool PERM = true, AFTER_DRAIN = false;
    bf16_t* O; float* small; const float* rstd; const float* tab; float* kmean; unsigned* kmaxh;
    __device__ __forceinline__ float bp(float v, int src) const { return __int_as_float(__builtin_amdgcn_ds_bpermute(src << 2, __float_as_int(v))); }
    __device__ __forceinline__ void operator()(const f32x4 (&acc)[2][2][4][2], const Unit& u, int wr, int wc, int fr, int fq) const {
        const int row0 = u.pm * BM + wr * 64 + fr, lane = fr + 16 * fq;
        if (u.pn < 8 || u.pn > 11) {
            const int col0 = u.pn * BM + wc * 32 + 8 * fq;
#pragma unroll
            for (int ai = 0; ai < 2; ++ai)
#pragma unroll
                for (int m = 0; m < 4; ++m) { const int row = row0 + ai * HALF + m * 16; const float rs = rstd[row]; bf16_t* rowp = O + (size_t)row * 3584 + col0;
#pragma unroll
                    for (int bj = 0; bj < 2; ++bj) { const f32x4 v0 = acc[ai][bj][m][0] * rs, v1 = acc[ai][bj][m][1] * rs;
                        u32x4 w; w.x = cvt_pk_bf16(v0[0], v0[1]); w.y = cvt_pk_bf16(v0[2], v0[3]); w.z = cvt_pk_bf16(v1[0], v1[1]); w.w = cvt_pk_bf16(v1[2], v1[3]);
                        *(u32x4*)(rowp + bj * HALF) = w; } }
        } else {
            typedef unsigned u32x2v __attribute__((ext_vector_type(2)));
            const bool isk = u.pn >= 10; const int g = 4 * (wc & 1) + fq;
#pragma unroll
            for (int bj = 0; bj < 2; ++bj) { const int hb = u.pn * BM + bj * HALF + (wc >> 1) * 64;
                f32x4 cs1 = {0.f, 0.f, 0.f, 0.f}, cs2 = {0.f, 0.f, 0.f, 0.f}; float nmax = 0.f;
#pragma unroll
                for (int ai = 0; ai < 2; ++ai)
#pragma unroll
                    for (int m = 0; m < 4; ++m) { const int row = row0 + ai * HALF + m * 16; const float rs = rstd[row]; const f32x4 a = acc[ai][bj][m][0] * rs, c = acc[ai][bj][m][1] * rs;
                        const float* tp = tab + ((size_t)(row & 8191) * 32 + 4 * g) * 2; const f32x4 t0 = *(const f32x4*)tp, t1 = *(const f32x4*)(tp + 4);
                        f32x4 o1, o2; o1[0] = a[0] * t0[0] - c[0] * t0[1]; o2[0] = c[0] * t0[0] + a[0] * t0[1]; o1[1] = a[1] * t0[2] - c[1] * t0[3]; o2[1] = c[1] * t0[2] + a[1] * t0[3];
                        o1[2] = a[2] * t1[0] - c[2] * t1[1]; o2[2] = c[2] * t1[0] + a[2] * t1[1]; o1[3] = a[3] * t1[2] - c[3] * t1[3]; o2[3] = c[3] * t1[2] + a[3] * t1[3];
                        u32x2v w1, w2; w1.x = cvt_pk_bf16(o1[0], o1[1]); w1.y = cvt_pk_bf16(o1[2], o1[3]); w2.x = cvt_pk_bf16(o2[0], o2[1]); w2.y = cvt_pk_bf16(o2[2], o2[3]);
                        bf16_t* rowp = O + (size_t)row * 3584 + hb + 4 * g; *(u32x2v*)rowp = w1; *(u32x2v*)(rowp + 32) = w2;
                        if (isk) { cs1 += o1; cs2 += o2; float n2 = (o1[0] * o1[0] + o1[1] * o1[1]) + (o1[2] * o1[2] + o1[3] * o1[3]) + (o2[0] * o2[0] + o2[1] * o2[1]) + (o2[2] * o2[2] + o2[3] * o2[3]);
                            n2 += bp(n2, lane ^ 16); n2 += bp(n2, lane ^ 32); nmax = fmaxf(nmax, n2); } }
                if (isk) {
#pragma unroll
                    for (int o = 1; o < 16; o <<= 1) {
#pragma unroll
                        for (int k = 0; k < 4; ++k) { cs1[k] += bp(cs1[k], lane ^ o); cs2[k] += bp(cs2[k], lane ^ o); }
                        nmax = fmaxf(nmax, bp(nmax, lane ^ o)); }
                    const int bh = (u.pm >> 5) * 8 + ((hb - 2560) >> 6), nblk = u.pm & 31;
                    if (fr == 0) { float* km = kmean + ((size_t)bh * 32 + nblk) * 64;
#pragma unroll
                        for (int k = 0; k < 4; ++k) { atomicAdd(km + 4 * g + k, cs1[k]); atomicAdd(km + 32 + 4 * g + k, cs2[k]); }
                        if (fq == 0) atomicMax(kmaxh + bh * 2 + (wc & 1), __float_as_uint(nmax)); }
                }
            }
        }
    }
};
struct EpiSwiglu {
    static constexpr bool PERM = true, AFTER_DRAIN = false;
    bf16_t* H; const float* rstd;
    __device__ __forceinline__ void operator()(const f32x4 (&acc)[2][2][4][2], const Unit& u, int wr, int wc, int fr, int fq) const {
        const int row0 = u.pm * BM + wr * 64 + fr, col0 = u.pn * HALF + wc * 32 + 8 * fq;
#pragma unroll
        for (int ai = 0; ai < 2; ++ai)
#pragma unroll
            for (int m = 0; m < 4; ++m) { const int row = row0 + ai * HALF + m * 16; const float rs = rstd[row]; bf16_t* rowp = H + (size_t)row * 2816 + col0;
                float h[8];
#pragma unroll
                for (int n = 0; n < 2; ++n)
#pragma unroll
                    for (int j = 0; j < 4; ++j) { const float g = acc[ai][0][m][n][j] * rs, up = acc[ai][1][m][n][j] * rs;
                        h[n * 4 + j] = g * __builtin_amdgcn_rcpf(1.0f + __expf(-g)) * up; }
                u32x4 w; w.x = cvt_pk_bf16(h[0], h[1]); w.y = cvt_pk_bf16(h[2], h[3]); w.z = cvt_pk_bf16(h[4], h[5]); w.w = cvt_pk_bf16(h[6], h[7]);
                *(u32x4*)rowp = w; }
    }
};
template <class Epi, class Sched, bool ALIGN_EPI = false, bool SP2 = false>
__device__ __forceinline__ void gemm_phase(PG8_LAS unsigned char* lds, const Gemm g, const Sched& S, const Epi& E, int tid_in) {
    int tid_ = tid_in; asm volatile("" : "+v"(tid_)); const int tid = tid_, wid = __builtin_amdgcn_readfirstlane(tid >> 6), lane = tid & 63, wr = wid >> 2, wc = wid & 3, fr = lane & 15, fq = lane >> 4;
    const int K = g.K, nt = K / BK;
    unsigned voffA[2], voffB[2];
#pragma unroll
    for (int i = 0; i < 2; ++i) { int R, C; stage_rc(tid * 16 + i * 8192, R, C); const int Rb = Epi::PERM ? ((R & ~31) + perm32(R & 31)) : R;
        voffA[i] = (unsigned)(R * K + C) * 2u; voffB[i] = (unsigned)(Rb * K + C) * 2u; }
    const size_t kstep = (size_t)(BK * 2);
    const size_t hstep = (size_t)HALF * K * 2;
    const size_t tstep = 2 * hstep;
    const unsigned ldsw = (unsigned)wid * 1024u;
    const int aoff = lds_byte(wr * 64 + fr, fq * 8), boff = lds_byte(wc * 32 + fr, fq * 8);
#define PG8_SA(b, h) (((b) * 2 + (h)) * HTB)
#define PG8_SB(b, h) ((4 + (b) * 2 + (h)) * HTB)
#define PG8_STAGE(bufoff, gbase, voff) do { _Pragma("unroll") for (int _i = 0; _i < 2; ++_i) \
        __builtin_amdgcn_global_load_lds((const unsigned*)((const char*)(gbase) + (voff)[_i]), (PG8_LAS unsigned*)(lds + (bufoff) + ldsw + _i * 8192), 16, 0, 0); } while (0)
#define PG8_LDA(dst, b, h) do { _Pragma("unroll") for (int m = 0; m < 4; ++m) _Pragma("unroll") for (int k = 0; k < 2; ++k) dst[m][k] = *(const PG8_LAS bf16x8*)(lds + PG8_SA(b, h) + aoff + m * 2048 + k * 1024); } while (0)
#define PG8_LDB(dst, b, h) do { _Pragma("unroll") for (int n = 0; n < 2; ++n) _Pragma("unroll") for (int k = 0; k < 2; ++k) dst[n][k] = *(const PG8_LAS bf16x8*)(lds + PG8_SB(b, h) + boff + n * 2048 + k * 1024); } while (0)
#define PG8_MMA(ai, bj, At, Bt) do { __builtin_amdgcn_s_setprio(1); _Pragma("unroll") for (int m = 0; m < 4; ++m) _Pragma("unroll") for (int n = 0; n < 2; ++n) _Pragma("unroll") for (int k = 0; k < 2; ++k) \
        acc[ai][bj][m][n] = __builtin_amdgcn_mfma_f32_16x16x32_bf16(Bt[n][k], At[m][k], acc[ai][bj][m][n], 0, 0, 0); __builtin_amdgcn_s_setprio(0); } while (0)
#define PG8_WAIT_V(n) asm volatile("s_waitcnt vmcnt(" #n ")" ::: "memory")
#define PG8_WAIT_L(n) asm volatile("s_waitcnt lgkmcnt(" #n ")" ::: "memory")
#define PG8_BAR __builtin_amdgcn_s_barrier()
#define PG8_SCHED __builtin_amdgcn_sched_barrier(0)
    Unit cur, nxt; int ui = 0;
    if (!S.next(0, cur)) return;
    f32x4 acc[2][2][4][2];
#pragma unroll
    for (int a = 0; a < 2; ++a)
#pragma unroll
        for (int b = 0; b < 2; ++b)
#pragma unroll
            for (int m = 0; m < 4; ++m)
#pragma unroll
                for (int n = 0; n < 2; ++n) acc[a][b][m][n] = (f32x4){0.f, 0.f, 0.f, 0.f};
    bf16x8 At[4][2], B0[2][2], B1[2][2];
    const char* cA = (const char*)g.A + (size_t)cur.pm * tstep; const char* cB = (const char*)g.Bt + (size_t)cur.pn * tstep;
    S.a_ready(cur);
    if constexpr (SP2) {
        PG8_STAGE(PG8_SB(0, 0), cB, voffB); PG8_STAGE(PG8_SB(0, 1), cB + hstep, voffB); PG8_STAGE(PG8_SA(0, 0), cA, voffA); PG8_STAGE(PG8_SA(0, 1), cA + hstep, voffA);
        if (wr == 1) PG8_BAR;
        PG8_WAIT_V(2); PG8_BAR;
        PG8_STAGE(PG8_SB(1, 0), cB + kstep, voffB); PG8_STAGE(PG8_SA(1, 0), cA + kstep, voffA); PG8_STAGE(PG8_SB(1, 1), cB + hstep + kstep, voffB);
        PG8_WAIT_V(6); PG8_BAR;
    } else {
        PG8_STAGE(PG8_SB(0, 0), cB, voffB); PG8_STAGE(PG8_SA(0, 0), cA, voffA); PG8_STAGE(PG8_SB(0, 1), cB + hstep, voffB); PG8_STAGE(PG8_SA(0, 1), cA + hstep, voffA);
        if (wr == 1) PG8_BAR;
        PG8_WAIT_V(4); PG8_BAR;
        PG8_STAGE(PG8_SB(1, 0), cB + kstep, voffB); PG8_STAGE(PG8_SA(1, 0), cA + kstep, voffA); PG8_STAGE(PG8_SB(1, 1), cB + hstep + kstep, voffB);
        PG8_WAIT_V(6); PG8_BAR;
    }
    for (;;) {
        const bool has_next = S.next(ui + 1, nxt);
        const char* nA = has_next ? (const char*)g.A + (size_t)nxt.pm * tstep : cA; const char* nB = has_next ? (const char*)g.Bt + (size_t)nxt.pn * tstep : cB;
        for (int t = 0; t < nt; t += 2) {
            const bool last = (t == nt - 2);
            const char* a1 = cA + (size_t)(t + 1) * kstep;
            const char* a2 = last ? nA : cA + (size_t)(t + 2) * kstep; const char* b2 = last ? nB : cB + (size_t)(t + 2) * kstep;
            const char* a3 = a2 + kstep; const char* b3 = b2 + kstep;
            if (last && has_next) S.a_ready(nxt);
            if constexpr (SP2) {
            PG8_LDB(B0, 0, 0); PG8_LDB(B1, 0, 1); PG8_SCHED; PG8_LDA(At, 0, 0); PG8_STAGE(PG8_SA(1, 1), a1 + hstep, voffA);
            PG8_WAIT_V(8); PG8_WAIT_L(0); PG8_BAR; PG8_MMA(0, 0, At, B0); PG8_MMA(0, 1, At, B1); PG8_BAR; PG8_SCHED;
            PG8_LDA(At, 0, 1); PG8_STAGE(PG8_SB(0, 0), b2, voffB); PG8_STAGE(PG8_SB(0, 1), b2 + hstep, voffB); PG8_STAGE(PG8_SA(0, 0), a2, voffA);
            PG8_WAIT_V(8); PG8_WAIT_L(0); PG8_BAR; PG8_MMA(1, 0, At, B0); PG8_MMA(1, 1, At, B1); PG8_BAR; PG8_SCHED;
            PG8_LDB(B0, 1, 0); PG8_LDB(B1, 1, 1); PG8_SCHED; PG8_LDA(At, 1, 0); PG8_STAGE(PG8_SA(0, 1), a2 + hstep, voffA);
            PG8_WAIT_V(8); PG8_WAIT_L(0); PG8_BAR; PG8_MMA(0, 0, At, B0); PG8_MMA(0, 1, At, B1); PG8_BAR; PG8_SCHED;
            PG8_LDA(At, 1, 1); PG8_STAGE(PG8_SB(1, 0), b3, voffB); PG8_STAGE(PG8_SB(1, 1), b3 + hstep, voffB); PG8_STAGE(PG8_SA(1, 0), a3, voffA);
            PG8_WAIT_V(8); PG8_WAIT_L(0); PG8_BAR; PG8_MMA(1, 0, At, B0); PG8_MMA(1, 1, At, B1); PG8_BAR; PG8_SCHED;
            } else {
            PG8_LDB(B0, 0, 0); PG8_SCHED; PG8_LDA(At, 0, 0); PG8_STAGE(PG8_SA(1, 1), a1 + hstep, voffA);
            PG8_WAIT_L(8); PG8_BAR; PG8_WAIT_L(0); PG8_MMA(0, 0, At, B0); PG8_BAR; PG8_SCHED;
            PG8_LDB(B1, 0, 1); PG8_STAGE(PG8_SB(0, 0), b2, voffB);
            PG8_BAR; PG8_WAIT_L(0); PG8_MMA(0, 1, At, B1); PG8_BAR;
            PG8_LDA(At, 0, 1); PG8_STAGE(PG8_SA(0, 0), a2, voffA);
            PG8_BAR; PG8_WAIT_L(0); PG8_MMA(1, 0, At, B0); PG8_BAR; PG8_SCHED;
            PG8_STAGE(PG8_SB(0, 1), b2 + hstep, voffB);
            PG8_WAIT_V(6); PG8_BAR; PG8_MMA(1, 1, At, B1); PG8_BAR;
            PG8_LDB(B0, 1, 0); PG8_SCHED; PG8_LDA(At, 1, 0); PG8_STAGE(PG8_SA(0, 1), a2 + hstep, voffA);
            PG8_WAIT_L(8); PG8_BAR; PG8_WAIT_L(0); PG8_MMA(0, 0, At, B0); PG8_BAR; PG8_SCHED;
            PG8_LDB(B1, 1, 1); PG8_STAGE(PG8_SB(1, 0), b3, voffB);
            PG8_BAR; PG8_WAIT_L(0); PG8_MMA(0, 1, At, B1); PG8_BAR;
            PG8_LDA(At, 1, 1); PG8_STAGE(PG8_SA(1, 0), a3, voffA);
            PG8_BAR; PG8_WAIT_L(0); PG8_MMA(1, 0, At, B0); PG8_BAR; PG8_SCHED;
            PG8_STAGE(PG8_SB(1, 1), b3 + hstep, voffB);
            PG8_WAIT_V(6); PG8_BAR; PG8_MMA(1, 1, At, B1); PG8_BAR;
            }
        }
        if constexpr (ALIGN_EPI) { if (wr == 0) PG8_BAR; }
        if constexpr (!Epi::AFTER_DRAIN) { E(acc, cur, wr, wc, fr, fq); S.done(cur); }
        if (!has_next) break;
#pragma unroll
        for (int a = 0; a < 2; ++a)
#pragma unroll
            for (int b = 0; b < 2; ++b)
#pragma unroll
                for (int m = 0; m < 4; ++m)
#pragma unroll
                    for (int n = 0; n < 2; ++n) acc[a][b][m][n] = (f32x4){0.f, 0.f, 0.f, 0.f};
        cur = nxt; cA = nA; cB = nB; ++ui;
        if constexpr (ALIGN_EPI) { if (wr == 1) PG8_BAR; }
    }
    PG8_WAIT_V(0);
    if constexpr (!ALIGN_EPI) { if (wr == 0) PG8_BAR; }
    PG8_BAR;
    if constexpr (Epi::AFTER_DRAIN) { E.fused(acc, cur, wr, wc, fr, fq, lds, wid, lane); S.done(cur); }
#undef PG8_SA
#undef PG8_SB
#undef PG8_STAGE
#undef PG8_LDA
#undef PG8_LDB
#undef PG8_MMA
#undef PG8_WAIT_V
#undef PG8_WAIT_L
#undef PG8_BAR
#undef PG8_SCHED
}
}
namespace cg = cooperative_groups;
constexpr int NWAVES = 8, NTHREADS = 512;
constexpr int BATCH = 4, SEQ = 8192, DM = 1024, MTOK = BATCH * SEQ, DEPTH = 2, NIN = 3608, NINP = 3840, PROJW = 3584, DFF = 2816;
constexpr int PC_GQ = 0, PC_GK = 256, PC_GV = 512, PC_GZ = 768, PC_DQ = 1024, PC_DK = 1280, PC_DV = 1536, PC_DZ = 1792, PC_MQ = 2048, PC_MK = 2560, PC_MV = 3072;
constexpr float RMS_EPS = 1e-6f;
constexpr size_t MiB = 1u << 20;
constexpr size_t WS_CTL = 0, CTL_ZERO_BYTES = 1 * MiB;
constexpr size_t WS_RSTD = 1 * MiB;
constexpr size_t WS_KMEAN = 256 * 1024;
constexpr size_t WS_KMAXH = 768 * 1024;
constexpr size_t WS_TAB = 2 * MiB;
constexpr size_t WS_SMALL = 4 * MiB;
constexpr size_t WS_W = 8 * MiB;
constexpr size_t W_IN_OFF = 0, W_O_OFF = (size_t)NINP * DM * 2, W_GU_OFF = W_O_OFF + (size_t)DM * DM * 2, W_D_OFF = W_GU_OFF + (size_t)2 * DFF * DM * 2, W_LAYER = 26 * MiB;
static_assert(W_D_OFF + (size_t)DM * DFF * 2 <= W_LAYER, "weights per layer");
constexpr size_t WS_XB = 64 * MiB;
constexpr size_t WS_PROJ = 128 * MiB;
constexpr size_t WS_MIX = 352 * MiB;
constexpr size_t WS_END = 416 * MiB;
constexpr int RING_BYTES = 131072, LDS_BYTES = 147456;

#define LAS __attribute__((address_space(3)))
typedef unsigned short bf16;
typedef unsigned v4u __attribute__((ext_vector_type(4)));
typedef unsigned v2u __attribute__((ext_vector_type(2)));
typedef float f32x4 __attribute__((ext_vector_type(4)));
#define LDS_WAIT() asm volatile("s_waitcnt lgkmcnt(0)" ::: "memory")
__device__ __forceinline__ unsigned f2bf(float f) { unsigned u = __builtin_bit_cast(unsigned, f); return (u + 0x7fffu + ((u >> 16) & 1u)) >> 16; }
typedef float f32x2_t __attribute__((ext_vector_type(2))); typedef __bf16 bf16x2_t __attribute__((ext_vector_type(2)));
__device__ __forceinline__ unsigned pk2(float lo, float hi) { const f32x2_t v = {lo, hi}; return __builtin_bit_cast(unsigned, __builtin_convertvector(v, bf16x2_t)); }
__device__ __forceinline__ float bf2f(unsigned short u) { return __builtin_bit_cast(float, (unsigned)u << 16); }
__device__ __forceinline__ float bflo(unsigned u) { return __builtin_bit_cast(float, u << 16); }
__device__ __forceinline__ float bfhi(unsigned u) { return __builtin_bit_cast(float, u & 0xffff0000u); }
__device__ __forceinline__ float bperm(float v, int srclane) { return __int_as_float(__builtin_amdgcn_ds_bpermute(srclane << 2, __float_as_int(v))); }
__device__ __forceinline__ float wave_sum(float v, int lane) {
#pragma unroll
    for (int o = 1; o < 64; o <<= 1) v += bperm(v, lane ^ o);
    return v;
}
__device__ __forceinline__ float wave_max(float v, int lane) {
#pragma unroll
    for (int o = 1; o < 64; o <<= 1) v = fmaxf(v, bperm(v, lane ^ o));
    return v;
}
__device__ __forceinline__ float rl(float v, int l) { return __int_as_float(__builtin_amdgcn_readlane(__float_as_int(v), l)); }
__device__ __forceinline__ float siluf(float z) { return z * __builtin_amdgcn_rcpf(1.f + __expf(-z)); }

struct Args { const float* in[17]; float* out; unsigned char* ws; int pad[2]; };
struct Frame {
    LAS unsigned char* lds; unsigned char* ldsg;
    int tid, lane, wave, G, bid, wave_s, layer;
    unsigned char* ws;
};
__device__ __forceinline__ void refresh(Frame& F, const Args& args) {
    int ln = (int)__builtin_amdgcn_mbcnt_hi(~0u, __builtin_amdgcn_mbcnt_lo(~0u, 0u)); asm volatile("" : "+v"(ln)); int wv = F.wave_s; asm volatile("" : "+s"(wv));
    F.lane = ln; F.wave = wv; F.tid = wv * 64 + ln;
    unsigned char* w = args.ws; asm volatile("" : "+s"(w)); F.ws = w;
    int b = blockIdx.x; asm volatile("" : "+s"(b)); F.bid = b;
}

__device__ __forceinline__ int inproj_src(int dn) {
    if (dn >= 2048 && dn < 3072) { const int hb = dn & ~63, p = dn & 63, g = p >> 3, j = p & 7; return hb + (j < 4 ? 4 * g + j : 32 + 4 * g + (j - 4)) + 24; }
    return dn < 1024 ? dn : dn < 2048 ? dn + 16 : dn < 3584 ? dn + 24 : dn < 3600 ? dn - 3584 + 1024 : dn < 3608 ? dn - 3600 + 2064 : -1; }
__device__ __forceinline__ void transpose_item(const float* W, int K, int N, const float* kscale, bf16* WT, int n0, int src4, int k0, LAS float* scr, int lane) {
    const int kq = lane >> 4, n4 = 4 * (lane & 15);
    f32x4 v[16];
#pragma unroll
    for (int i = 0; i < 16; ++i) { const int kk = 4 * i + kq; v[i] = (f32x4){0.f, 0.f, 0.f, 0.f}; if (src4 >= 0) v[i] = __builtin_nontemporal_load((const f32x4*)(W + (size_t)(k0 + kk) * N + src4)); }
#pragma unroll
    for (int i = 0; i < 16; ++i) { const int kk = 4 * i + kq; const float sc = kscale ? kscale[k0 + kk] : 1.f;
        scr[(n4 + 0) * 65 + kk] = v[i].x * sc; scr[(n4 + 1) * 65 + kk] = v[i].y * sc; scr[(n4 + 2) * 65 + kk] = v[i].z * sc; scr[(n4 + 3) * 65 + kk] = v[i].w * sc; }
    LDS_WAIT(); asm volatile("" ::: "memory");
    const int c = lane & 7;
#pragma unroll
    for (int j = 0; j < 8; ++j) { const int n = (lane >> 3) + 8 * j; const LAS float* sp = scr + n * 65 + 8 * c;
        v4u o; o.x = pk2(sp[0], sp[1]); o.y = pk2(sp[2], sp[3]); o.z = pk2(sp[4], sp[5]); o.w = pk2(sp[6], sp[7]);
        *(v4u*)(WT + (size_t)(n0 + n) * K + k0 + 8 * c) = o; }
    LDS_WAIT(); asm volatile("" ::: "memory");
}
constexpr int W_ITEMS_EARLY = 16 * (NINP / 64) + 16 * 16, W_ITEMS_ALL = W_ITEMS_EARLY + 16 * (2 * DFF / 64) + (DFF / 64) * 16;
__device__ __forceinline__ void p0_weights(Frame& F, const Args& a, int lA, int lB, int w0, int nw, int lo, int hi) {
    LAS float* scr = (LAS float*)(F.lds + F.wave * 16896);
    constexpr int I_IN = 16 * (NINP / 64), I_O = 16 * 16, I_GU = 16 * (2 * DFF / 64);
    const int n4 = 4 * (F.lane & 15);
    for (int it = lo + w0; it < hi; it += nw) {
        const int l = it < W_ITEMS_EARLY ? lA : lB;
        unsigned char* wl = F.ws + WS_W + (size_t)l * W_LAYER;
        int r = it;
        if (r < I_IN) { const int kb = r / (NINP / 64), nb = r % (NINP / 64); transpose_item(a.in[5] + (size_t)l * DM * NIN, DM, NIN, a.in[1] + l * DM, (bf16*)(wl + W_IN_OFF), nb * 64, inproj_src(nb * 64 + n4), kb * 64, scr, F.lane); continue; } r -= I_IN;
        if (r < I_O) { const int kb = r / 16, nb = r % 16; transpose_item(a.in[6] + (size_t)l * DM * DM, DM, DM, nullptr, (bf16*)(wl + W_O_OFF), nb * 64, nb * 64 + n4, kb * 64, scr, F.lane); continue; } r -= I_O;
        if (r < I_GU) { const int kb = r / (2 * DFF / 64), nb = r % (2 * DFF / 64); const int dn = nb * 64; const int pn = dn >> 8, within = dn & 255;
            const float* W = (within < 128 ? a.in[14] : a.in[15]) + (size_t)l * DM * DFF; const int col = pn * 128 + (within & 127) + n4;
            transpose_item(W, DM, DFF, a.in[3] + l * DM, (bf16*)(wl + W_GU_OFF), dn, col, kb * 64, scr, F.lane); continue; } r -= I_GU;
        { const int kb = r / 16, nb = r % 16; transpose_item(a.in[16] + (size_t)l * DFF * DM, DFF, DM, nullptr, (bf16*)(wl + W_D_OFF), nb * 64, nb * 64 + n4, kb * 64, scr, F.lane); }
    }
}
__device__ __forceinline__ void p0_table(Frame& F) {
    float* tab = (float*)(F.ws + WS_TAB);
    for (int idx = F.bid * NTHREADS + F.tid; idx < SEQ * 32; idx += F.G * NTHREADS) {
        const int pos = idx >> 5, i = idx & 31;
        const float inv = powf(10000.f, -(float)i / 32.f); const float ang = (float)pos * inv;
        tab[2 * idx] = cosf(ang); tab[2 * idx + 1] = sinf(ang);
    }
}
constexpr int NORM_RB = 8;
__device__ __forceinline__ void p0_xb(Frame& F, const float* x, bf16* XB) {
    float* RSTD = (float*)(F.ws + WS_RSTD);
    const int gw = F.bid * NWAVES + F.wave, NGW = F.G * NWAVES;
    for (int m0 = gw * NORM_RB; m0 < MTOK; m0 += NGW * NORM_RB) {
        f32x4 v[NORM_RB][4];
#pragma unroll
        for (int u = 0; u < NORM_RB; ++u) { const f32x4* xr = (const f32x4*)(x + (size_t)(m0 + u) * DM) + F.lane;
#pragma unroll
            for (int j = 0; j < 4; ++j) v[u][j] = __builtin_nontemporal_load(xr + 64 * j); }
#pragma unroll
        for (int u = 0; u < NORM_RB; ++u) { float s = 0.f;
#pragma unroll
            for (int j = 0; j < 4; ++j) s += (v[u][j].x * v[u][j].x + v[u][j].y * v[u][j].y) + (v[u][j].z * v[u][j].z + v[u][j].w * v[u][j].w);
            s = wave_sum(s, F.lane);
            v2u* o = (v2u*)(XB + (size_t)(m0 + u) * DM) + F.lane;
#pragma unroll
            for (int j = 0; j < 4; ++j) { v2u w; w.x = pk2(v[u][j].x, v[u][j].y); w.y = pk2(v[u][j].z, v[u][j].w); o[64 * j] = w; }
            if (F.lane == 0) RSTD[m0 + u] = rsqrtf(s * (1.f / DM) + RMS_EPS); }
    }
}
__device__ __forceinline__ void norm_pass(Frame& F, const bf16* rsrc, bf16* rdst, float* out, const float* w, bool last) {
    const bf16* Y = (const bf16*)(F.ws + WS_XB); float* RSTD = (float*)(F.ws + WS_RSTD);
    const int gw = F.bid * NWAVES + F.wave, NGW = F.G * NWAVES;
    f32x4 wv[4];
#pragma unroll
    for (int j = 0; j < 4; ++j) wv[j] = ((const f32x4*)w)[64 * j + F.lane];
    for (int m0 = gw * NORM_RB; m0 < MTOK; m0 += NGW * NORM_RB) {
        v2u yu[NORM_RB][4], xu[NORM_RB][4];
#pragma unroll
        for (int u = 0; u < NORM_RB; ++u) { const v2u* yr = (const v2u*)(Y + (size_t)(m0 + u) * DM) + F.lane; const v2u* xr = (const v2u*)(rsrc + (size_t)(m0 + u) * DM) + F.lane;
#pragma unroll
            for (int j = 0; j < 4; ++j) { yu[u][j] = __builtin_nontemporal_load(yr + 64 * j); xu[u][j] = __builtin_nontemporal_load(xr + 64 * j); } }
#pragma unroll
        for (int u = 0; u < NORM_RB; ++u) { f32x4 y[4], xv[4]; float s = 0.f;
#pragma unroll
            for (int j = 0; j < 4; ++j) { y[j] = (f32x4){bflo(yu[u][j].x), bfhi(yu[u][j].x), bflo(yu[u][j].y), bfhi(yu[u][j].y)}; s += (y[j].x * y[j].x + y[j].y * y[j].y) + (y[j].z * y[j].z + y[j].w * y[j].w); }
            s = wave_sum(s, F.lane); const float r = rsqrtf(s * (1.f / DM) + RMS_EPS); float s2 = 0.f;
#pragma unroll
            for (int j = 0; j < 4; ++j) { xv[j] = (f32x4){bflo(xu[u][j].x), bfhi(xu[u][j].x), bflo(xu[u][j].y), bfhi(xu[u][j].y)} + y[j] * r * wv[j]; s2 += (xv[j].x * xv[j].x + xv[j].y * xv[j].y) + (xv[j].z * xv[j].z + xv[j].w * xv[j].w); }
            if (last) { f32x4* xo = (f32x4*)(out + (size_t)(m0 + u) * DM) + F.lane;
#pragma unroll
                for (int j = 0; j < 4; ++j) __builtin_nontemporal_store(xv[j], xo + 64 * j); }
            else { s2 = wave_sum(s2, F.lane); v2u* o = (v2u*)(rdst + (size_t)(m0 + u) * DM) + F.lane;
#pragma unroll
                for (int j = 0; j < 4; ++j) { v2u wq; wq.x = pk2(xv[j].x, xv[j].y); wq.y = pk2(xv[j].z, xv[j].w); o[64 * j] = wq; }
                if (F.lane == 0) RSTD[m0 + u] = rsqrtf(s2 * (1.f / DM) + RMS_EPS); } }
    }
}
#define XB_TMO      128
#define XB_XCNT(j)  (256  + 64 * (j))
#define XB_XSUB(j)  (1280 + 64 * (j))
#define XB_XGEN(j)  (2304 + 64 * (j))
#define XB_TOP      3328
#define XB_TOPGEN   3392
#define XCD_BAR_WORDS 3456
#define XB_SPIN_CAP (1u << 22)

__device__ __forceinline__ unsigned xb_ld(unsigned* p)              { return __hip_atomic_load(p, __ATOMIC_RELAXED, __HIP_MEMORY_SCOPE_AGENT); }
__device__ __forceinline__ unsigned xb_add(unsigned* p, unsigned v) { return __hip_atomic_fetch_add(p, v, __ATOMIC_RELAXED, __HIP_MEMORY_SCOPE_AGENT); }
__device__ __forceinline__ unsigned xb_xcc_id() { return (unsigned)__builtin_amdgcn_s_getreg((3 << 11) | 20) & 0xFu; }
#define XB_SPIN(cond, bar) do { unsigned _sp = 0; while (cond) { __builtin_amdgcn_s_sleep(1); \
    if ((++_sp & 255u) == 0u) { if (xb_ld(&(bar)[XB_TMO])) break; if (_sp > XB_SPIN_CAP) { atomicAdd(&(bar)[XB_TMO], 1u); break; } } } } while (0)

struct XcdBarrier {
    unsigned* bar; unsigned x;
    volatile LAS unsigned* st;
};

__device__ __forceinline__ XcdBarrier xcd_barrier_post(unsigned* bar, volatile LAS unsigned* st) {
    XcdBarrier b; b.bar = bar; b.x = xb_xcc_id(); b.st = st;
    if (threadIdx.x == 0) (void)xb_add(&bar[XB_XCNT(b.x)], 1u);
    return b;
}
__device__ __forceinline__ void xcd_barrier_complete(unsigned* bar, unsigned x, unsigned& nloc, unsigned& nx) {
    const unsigned G = gridDim.x * gridDim.y * gridDim.z;
    unsigned sum, cnt, mine, sp = 0u;
    for (;;) {
        sum = 0u; cnt = 0u; mine = 0u;
#pragma unroll
        for (unsigned j = 0; j < 16; ++j) { const unsigned c = xb_ld(&bar[XB_XCNT(j)]); sum += c; cnt += (c > 0u) ? 1u : 0u; mine = (j == x) ? c : mine; }
        if (sum == G) break;
        __builtin_amdgcn_s_sleep(1);
        if ((++sp & 255u) == 0u) { if (xb_ld(&bar[XB_TMO])) break; if (sp > XB_SPIN_CAP) { atomicAdd(&bar[XB_TMO], 1u); break; } }
    }
    nloc = mine > 0u ? mine : 1u; nx = cnt > 0u ? cnt : 1u;
}

__device__ __forceinline__ void xcd_barrier(const XcdBarrier& b) {
    asm volatile("s_waitcnt vmcnt(0)" ::: "memory");
    __syncthreads();
    if (threadIdx.x == 0) {
        unsigned* bar = b.bar;
        __builtin_amdgcn_s_waitcnt(0);
        unsigned nloc = b.st[0], nx = b.st[1];
        if (nloc == 0u) { xcd_barrier_complete(bar, b.x, nloc, nx); b.st[0] = nloc; b.st[1] = nx; }
        const unsigned old = xb_add(&bar[XB_XSUB(b.x)], 1u);
        const unsigned gen = old / nloc;
        if (old + 1u == (gen + 1u) * nloc) {
            __builtin_amdgcn_fence(__ATOMIC_RELEASE, "agent");
            asm volatile("s_waitcnt vmcnt(0)" ::: "memory");
            const unsigned og = xb_add(&bar[XB_TOP], 1u);
            const unsigned tg = og / nx;
            if (og + 1u == (tg + 1u) * nx) xb_add(&bar[XB_TOPGEN], 1u);
            else XB_SPIN(xb_ld(&bar[XB_TOPGEN]) == tg, bar);
            __builtin_amdgcn_fence(__ATOMIC_ACQUIRE, "agent");
            xb_add(&bar[XB_XGEN(b.x)], 1u);
            asm volatile("s_waitcnt vmcnt(0)" ::: "memory");
        } else {
            XB_SPIN(xb_ld(&bar[XB_XGEN(b.x)]) == gen, bar);
            __builtin_amdgcn_fence(__ATOMIC_ACQUIRE, "agent");
            asm volatile("s_waitcnt vmcnt(0)" ::: "memory");
        }
    }
    __syncthreads();
}
typedef short bf16x8 __attribute__((ext_vector_type(8)));
typedef float f32x16 __attribute__((ext_vector_type(16)));
constexpr size_t WS_GLA_S = 416 * MiB;
constexpr size_t WS_GDN_M = 432 * MiB;
constexpr size_t WS_GDN_N = 448 * MiB;
__device__ __forceinline__ int gdn_slot(int item) { return item; }
constexpr size_t WS_GLA_DEC = 464 * MiB;
constexpr size_t WS_GDN_GB = 465 * MiB;
constexpr size_t WS_END2 = 468 * MiB;
constexpr size_t WS_GDN_QC = WS_XB, WS_GDN_KN = WS_XB + 16 * MiB, WS_GDN_W = WS_XB + 32 * MiB, WS_GDN_UT = WS_XB + 48 * MiB;

typedef __attribute__((address_space(1))) unsigned short GBF;
template <typename T> __device__ __forceinline__ T* opq_ptr(T* p) { asm volatile("" : "+v"(p)); return p; }
__device__ __forceinline__ f32x16 mfma32(bf16x8 a, bf16x8 b, f32x16 c) { return __builtin_amdgcn_mfma_f32_32x32x16_bf16(a, b, c, 0, 0, 0); }
__device__ __forceinline__ int crow(int reg, int hh) { return (reg & 3) + 8 * (reg >> 2) + 4 * hh; }
__device__ __forceinline__ bf16x8 mk8(unsigned a, unsigned b, unsigned c, unsigned d) { v4u t = {a, b, c, d}; return __builtin_bit_cast(bf16x8, t); }
__device__ __forceinline__ bf16x8 acc_frag(const f32x16& x, int s) {
    return mk8(pk2(x[8 * s + 0], x[8 * s + 1]), pk2(x[8 * s + 2], x[8 * s + 3]), pk2(x[8 * s + 4], x[8 * s + 5]), pk2(x[8 * s + 6], x[8 * s + 7]));
}
__device__ __forceinline__ void tok_frags(const unsigned (&pk)[32], int ks, bf16x8& f0, bf16x8& f1) {
    unsigned a[4], b[4];
#pragma unroll
    for (int q = 0; q < 4; ++q) { auto rr = __builtin_amdgcn_permlane32_swap(pk[8 * ks + q], pk[8 * ks + 4 + q], false, false); a[q] = rr[0]; b[q] = rr[1]; }
    f0 = mk8(a[0], a[1], a[2], a[3]); f1 = mk8(b[0], b[1], b[2], b[3]);
}
__device__ __forceinline__ void store_acc_order(bf16* base, const f32x16 (&acc)[2][2], int lane) {
#pragma unroll
    for (int nb = 0; nb < 2; ++nb)
#pragma unroll
        for (int mb = 0; mb < 2; ++mb)
#pragma unroll
            for (int g = 0; g < 4; ++g) { v2u w; w.x = pk2(acc[mb][nb][4 * g], acc[mb][nb][4 * g + 1]); w.y = pk2(acc[mb][nb][4 * g + 2], acc[mb][nb][4 * g + 3]);
                *(v2u*)(base + ((nb * 2 + mb) * 4 + g) * 256 + lane * 4) = w; }
}
__device__ __forceinline__ bf16x8 load_acc_frag(const bf16* base, int nb, int mb, int s, int lane) {
    const v2u lo = *(const v2u*)(base + ((nb * 2 + mb) * 4 + 2 * s) * 256 + lane * 4), hi = *(const v2u*)(base + ((nb * 2 + mb) * 4 + 2 * s + 1) * 256 + lane * 4);
    return mk8(lo.x, lo.y, hi.x, hi.y);
}
__device__ __forceinline__ void store_row32_wide(bf16* blk, const v2u (&pkd)[4], int hh) {
#pragma unroll
    for (int gp = 0; gp < 4; gp += 2) { const auto rx = __builtin_amdgcn_permlane32_swap(pkd[gp].x, pkd[gp + 1].x, false, false), ry = __builtin_amdgcn_permlane32_swap(pkd[gp].y, pkd[gp + 1].y, false, false);
        v4u w = {rx[0], ry[0], rx[1], ry[1]}; *(v4u*)(blk + 8 * gp + 8 * hh) = w; }
}
__device__ __forceinline__ bf16x8 load_row_frag(const bf16* p) { const v2u lo = *(const v2u*)p, hi = *(const v2u*)(p + 8); return mk8(lo.x, lo.y, hi.x, hi.y); }

typedef float f32x4m __attribute__((ext_vector_type(4)));
__device__ __forceinline__ void small_proj_tile(Frame& F, const bf16* XBp, const bf16* Win, const float* rstd, int tile) {
    int lane_ = F.lane; asm volatile("" : "+v"(lane_)); const int lane = lane_, fr = lane & 15, fq = lane >> 4;
    const bf16* ap = XBp + (size_t)(tile * 16 + fr) * DM + 8 * fq;
    const bf16* bp0 = Win + (size_t)(3584 + fr) * DM + 8 * fq; const bf16* bp1 = Win + (size_t)(3600 + fr) * DM + 8 * fq;
    f32x4m acc0 = {0.f, 0.f, 0.f, 0.f}, acc1 = {0.f, 0.f, 0.f, 0.f};
#pragma unroll 8
    for (int ks = 0; ks < 32; ++ks) { const bf16x8 a = *(const bf16x8*)(ap + 32 * ks), b0 = *(const bf16x8*)(bp0 + 32 * ks), b1 = *(const bf16x8*)(bp1 + 32 * ks);
        acc0 = __builtin_amdgcn_mfma_f32_16x16x32_bf16(a, b0, acc0, 0, 0, 0); acc1 = __builtin_amdgcn_mfma_f32_16x16x32_bf16(a, b1, acc1, 0, 0, 0); }
    float* SM = (float*)(F.ws + WS_SMALL);
#pragma unroll
    for (int q = 0; q < 4; ++q) { const int row = tile * 16 + 4 * fq + q; const float rs = rstd[row];
        SM[(size_t)row * 32 + fr] = acc0[q] * rs; if (fr < 8) SM[(size_t)row * 32 + 16 + fr] = acc1[q] * rs; }
}
constexpr int JUNK_OFF = 135168;
__device__ __forceinline__ void warm_block(Frame& F, const void* base, size_t pitch, int rows, int lane) {
    LAS unsigned* junk = (LAS unsigned*)(F.lds + JUNK_OFF + F.wave * 1024);
    const unsigned char* p = (const unsigned char*)base + (size_t)(lane >> 3) * pitch + (lane & 7) * 16;
    for (int r = 0; r < rows; r += 8) { if (r + (lane >> 3) < rows) __builtin_amdgcn_global_load_lds((const unsigned*)(p + (size_t)r * pitch), junk, 16, 0, 0); }
}
__device__ __forceinline__ void gla_a_warm(Frame& F, int item) {
    const int c = item & 127, bh = item >> 7, h = bh & 3, b = bh >> 2, lane = F.lane; const size_t r0 = (size_t)b * SEQ + (size_t)c * 64;
    const bf16* wb = (const bf16*)(F.ws + WS_PROJ) + r0 * PROJW + h * 64;
    warm_block(F, (const float*)(F.ws + WS_SMALL) + r0 * 32, 128, 64, lane); warm_block(F, wb + PC_GK, PROJW * 2, 64, lane); warm_block(F, wb + PC_GQ, PROJW * 2, 64, lane); warm_block(F, wb + PC_GV, PROJW * 2, 64, lane);
}
template <bool DRY>
__device__ __forceinline__ void gla_a_item_t(Frame& F, const Args& a, int l, int item) {
    const int c = item & 127, bh = item >> 7, h = bh & 3, b = bh >> 2; int lane_ = F.lane; asm volatile("" : "+v"(lane_)); const int lane = lane_;
    const size_t r0 = (size_t)b * SEQ + (size_t)c * 64;
    bf16* PR = (bf16*)(F.ws + WS_PROJ) + r0 * PROJW + h * 64 + lane;
    const __attribute__((address_space(1))) float* SM = (const __attribute__((address_space(1))) float*)(F.ws + WS_SMALL) + r0 * 32;
    float wg[16];
#pragma unroll
    for (int r = 0; r < 16; ++r) wg[r] = a.in[7][(size_t)l * 4096 + r * 256 + h * 64 + lane];
    const float bias = a.in[8][l * 256 + h * 64 + lane];
    float cum[64]; float run = 0.f;
#pragma unroll
    for (int t = 0; t < 64; ++t) { float s = bias;
#pragma unroll
        for (int r = 0; r < 16; ++r) s = fmaf(SM[t * 32 + r], wg[r], s);
        run += (fminf(s, 0.f) - __logf(1.f + __expf(-fabsf(s)))) * (1.f / 16.f); cum[t] = run; }
    const float last = run;
    unsigned kk[32], vv[32];
#define GLA_A_QUARTER(Q) { unsigned short kr[16], qr[16], vr[16]; GBF* PRt = (GBF*)PR + (size_t)(16 * (Q)) * PROJW; \
        _Pragma("unroll") for (int i = 0; i < 16; ++i) { kr[i] = PRt[PC_GK]; qr[i] = PRt[PC_GQ]; vr[i] = PRt[PC_GV]; PRt = opq_ptr(PRt + PROJW); } \
        GBF* PRs = (GBF*)PR + (size_t)(16 * (Q)) * PROJW; \
        _Pragma("unroll") for (int i2 = 0; i2 < 8; ++i2) { float k2[2]; \
            _Pragma("unroll") for (int u = 0; u < 2; ++u) { const int i = 2 * i2 + u, t = 16 * (Q) + i; GBF* p = PRs; PRs = opq_ptr(PRs + PROJW); const float kf = bf2f(kr[i]), qf = bf2f(qr[i]); \
                { const bf16 q_ = (bf16)f2bf(qf * 0.125f * __expf(cum[t])), k_ = (bf16)f2bf(kf * __expf(-cum[t])); if (DRY) { asm volatile("" :: "v"((unsigned)q_), "v"((unsigned)k_)); } else { p[PC_GQ] = q_; p[PC_GK] = k_; } } k2[u] = kf * __expf(last - cum[t]); } \
            kk[8 * (Q) + i2] = pk2(k2[0], k2[1]); vv[8 * (Q) + i2] = (unsigned)vr[2 * i2] | ((unsigned)vr[2 * i2 + 1] << 16); } \
        asm volatile("" ::: "memory"); }
    GLA_A_QUARTER(0) GLA_A_QUARTER(1) GLA_A_QUARTER(2) GLA_A_QUARTER(3)
#undef GLA_A_QUARTER
    { bf16* vtp = (bf16*)(F.ws + WS_PROJ) + (r0 + lane) * PROJW + PC_GV + h * 64;
#pragma unroll
      for (int q = 0; q < 8; ++q) { v4u o = {vv[4 * q], vv[4 * q + 1], vv[4 * q + 2], vv[4 * q + 3]}; if (!DRY) *(v4u*)(vtp + 8 * q) = o; } }
    ((float*)(F.ws + WS_GLA_DEC))[(size_t)item * 64 + lane] = __expf(last);
    f32x16 acc[2][2];
#pragma unroll
    for (int i = 0; i < 2; ++i)
#pragma unroll
        for (int j = 0; j < 2; ++j)
#pragma unroll
            for (int r = 0; r < 16; ++r) acc[i][j][r] = 0.f;
#pragma unroll
    for (int ks = 0; ks < 4; ++ks) { bf16x8 ka[2], vb[2]; tok_frags(kk, ks, ka[0], ka[1]); tok_frags(vv, ks, vb[0], vb[1]);
#pragma unroll
        for (int mb = 0; mb < 2; ++mb)
#pragma unroll
            for (int nb = 0; nb < 2; ++nb) acc[mb][nb] = mfma32(ka[mb], vb[nb], acc[mb][nb]); }
    store_acc_order((bf16*)(F.ws + WS_GLA_S) + (size_t)item * 4096, acc, lane);
}
__device__ __forceinline__ void gla_a_item(Frame& F, const Args& a, int l, int item) { gla_a_item_t<false>(F, a, l, item); }
__device__ __forceinline__ void gla_scan(Frame& F, int gidx) {
    const int bh = gidx >> 10, within = gidx & 1023, L = within & 63, g = (within >> 6) & 3, mb = (within >> 8) & 1;
    const int d0 = 32 * mb + 8 * g + 4 * (L >> 5);
    bf16* base = (bf16*)(F.ws + WS_GLA_S) + (size_t)bh * 128 * 4096 + within * 4; const float* dec = (const float*)(F.ws + WS_GLA_DEC) + (size_t)bh * 128 * 64 + d0;
    f32x4 S = {0.f, 0.f, 0.f, 0.f};
    for (int c0 = 0; c0 < 128; c0 += 16) {
        v2u ds[16]; f32x4 dc[16];
#pragma unroll
        for (int u = 0; u < 16; ++u) { ds[u] = *(const v2u*)(base + (size_t)(c0 + u) * 4096); dc[u] = *(const f32x4*)(dec + (size_t)(c0 + u) * 64); }
#pragma unroll
        for (int u = 0; u < 16; ++u) { v2u w; w.x = pk2(S.x, S.y); w.y = pk2(S.z, S.w); *(v2u*)(base + (size_t)(c0 + u) * 4096) = w;
            S.x = fmaf(dc[u].x, S.x, bflo(ds[u].x)); S.y = fmaf(dc[u].y, S.y, bfhi(ds[u].x)); S.z = fmaf(dc[u].z, S.z, bflo(ds[u].y)); S.w = fmaf(dc[u].w, S.w, bfhi(ds[u].y)); }
    }
}
__device__ __forceinline__ void gla_c_item(Frame& F, const Args& a, int l, int item) {
    const int c = item & 127, bh = item >> 7, h = bh & 3, b = bh >> 2; int lane_ = F.lane; asm volatile("" : "+v"(lane_)); const int lane = lane_, r = lane & 31, hh = lane >> 5;
    const size_t r0 = (size_t)b * SEQ + (size_t)c * 64;
    const bf16* PR = (const bf16*)(F.ws + WS_PROJ) + r0 * PROJW + h * 64;
    const bf16* Sb = (const bf16*)(F.ws + WS_GLA_S) + (size_t)item * 4096;
    bf16x8 qf[2][2][2], kf[2][2][2];
#pragma unroll
    for (int ib = 0; ib < 2; ++ib)
#pragma unroll
        for (int mb = 0; mb < 2; ++mb)
#pragma unroll
            for (int s = 0; s < 2; ++s) { const size_t off = (size_t)(r + 32 * ib) * PROJW + 32 * mb + 16 * s + 4 * hh;
                qf[ib][mb][s] = load_row_frag(PR + off + PC_GQ); kf[ib][mb][s] = load_row_frag(PR + off + PC_GK); }
    f32x16 pt[2][2], ot[2][2];
#pragma unroll
    for (int i = 0; i < 2; ++i)
#pragma unroll
        for (int j = 0; j < 2; ++j)
#pragma unroll
            for (int q = 0; q < 16; ++q) { pt[i][j][q] = 0.f; ot[i][j][q] = 0.f; }
#pragma unroll
    for (int jb = 0; jb < 2; ++jb)
#pragma unroll
        for (int ib = 0; ib < 2; ++ib) { if (jb == 1 && ib == 0) continue;
#pragma unroll
            for (int mb = 0; mb < 2; ++mb)
#pragma unroll
                for (int s = 0; s < 2; ++s) pt[jb][ib] = mfma32(kf[jb][mb][s], qf[ib][mb][s], pt[jb][ib]); }
#pragma unroll
    for (int q = 0; q < 16; ++q) { if (crow(q, hh) > r) { pt[0][0][q] = 0.f; pt[1][1][q] = 0.f; } }
#pragma unroll
    for (int eb = 0; eb < 2; ++eb)
#pragma unroll
        for (int mb = 0; mb < 2; ++mb)
#pragma unroll
            for (int s = 0; s < 2; ++s) { const bf16x8 sf = load_acc_frag(Sb, eb, mb, s, lane);
#pragma unroll
                for (int ib = 0; ib < 2; ++ib) ot[eb][ib] = mfma32(sf, qf[ib][mb][s], ot[eb][ib]); }
#pragma unroll
    for (int jb = 0; jb < 2; ++jb)
#pragma unroll
        for (int s = 0; s < 2; ++s) {
            bf16x8 vf[2];
#pragma unroll
            for (int eb = 0; eb < 2; ++eb) vf[eb] = load_row_frag(PR + (size_t)(r + 32 * eb) * PROJW + PC_GV + 32 * jb + 16 * s + 4 * hh);
#pragma unroll
            for (int ib = 0; ib < 2; ++ib) { if (jb == 1 && ib == 0) continue; const bf16x8 pf = acc_frag(pt[jb][ib], s);
#pragma unroll
                for (int eb = 0; eb < 2; ++eb) ot[eb][ib] = mfma32(vf[eb], pf, ot[eb][ib]); }
        }
    const float* nw = a.in[9] + l * 64; bf16* MIXp = (bf16*)(F.ws + WS_MIX);
#pragma unroll
    for (int ib = 0; ib < 2; ++ib) { float ss = 0.f;
#pragma unroll
        for (int eb = 0; eb < 2; ++eb)
#pragma unroll
            for (int q = 0; q < 16; ++q) ss = fmaf(ot[eb][ib][q], ot[eb][ib][q], ss);
        ss += bperm(ss, lane ^ 32); const float rs = rsqrtf(ss * (1.f / 64.f) + RMS_EPS);
        const size_t row = r0 + r + 32 * ib;
#pragma unroll
        for (int eb = 0; eb < 2; ++eb) { v2u pkd[4];
#pragma unroll
            for (int g = 0; g < 4; ++g) { const int e0 = 32 * eb + 8 * g + 4 * hh;
                const v2u zz = *(const v2u*)(PR + (size_t)(r + 32 * ib) * PROJW + PC_GZ + e0); const f32x4 w4 = *(const f32x4*)(nw + e0);
                const float y0 = ot[eb][ib][4 * g] * rs * w4.x * siluf(bflo(zz.x)), y1 = ot[eb][ib][4 * g + 1] * rs * w4.y * siluf(bfhi(zz.x));
                const float y2 = ot[eb][ib][4 * g + 2] * rs * w4.z * siluf(bflo(zz.y)), y3 = ot[eb][ib][4 * g + 3] * rs * w4.w * siluf(bfhi(zz.y));
                pkd[g].x = pk2(y0, y1); pkd[g].y = pk2(y2, y3); }
            store_row32_wide(MIXp + row * DM + h * 64 + 32 * eb, pkd, hh); }
    }
}
constexpr int GDN_TAB_OFF = 131072;
#ifndef GDN_LOCKSTEP
#define GDN_LOCKSTEP 1
#endif
#if GDN_LOCKSTEP
#define GDN_LSYNC() __builtin_amdgcn_s_barrier()
#else
#define GDN_LSYNC() do {} while (0)
#endif
__device__ __forceinline__ float wave_incl_scan(float v, int lane) {
#pragma unroll
    for (int o = 1; o < 64; o <<= 1) { const float n = bperm(v, lane - o); if (lane >= o) v += n; }
    return v;
}
__device__ __forceinline__ void gdn_solve64(float (&X)[64], const LAS float* Lm) {
#pragma unroll
    for (int t = 0; t < 64; ++t) asm volatile("" : "+v"(X[t]));
#pragma unroll
    for (int i = 1; i < 64; ++i) {
#pragma unroll
        for (int jg = 0; jg < (i + 3) / 4; ++jg) { const f32x4 l4 = *(const LAS f32x4*)(Lm + i * 64 + 4 * jg);
#pragma unroll
            for (int jj = 0; jj < 4; ++jj) { const int j = 4 * jg + jj; if (j < i) X[i] = fmaf(-l4[jj], X[j], X[i]); } }
    }
#pragma unroll
    for (int t = 0; t < 64; ++t) asm volatile("" : "+v"(X[t]));
}
#define GDN_CONV_HALF(COLOFF, OUT, HF) { float x_[35]; const GBF* p_ = (const GBF*)PRq + (ptrdiff_t)(32 * (HF) - 3) * PROJW + (COLOFF); \
        _Pragma("unroll") for (int i_ = 0; i_ < 35; ++i_) { const int t_ = 32 * (HF) + i_ - 3; \
            if (t_ < 0) { const GBF* q_ = first ? (const GBF*)PRq + (COLOFF) : p_; const float v_ = bf2f(*q_); x_[i_] = first ? 0.f : v_; } else x_[i_] = bf2f(*p_); \
            p_ = opq_ptr(p_ + PROJW); } \
        _Pragma("unroll") for (int i_ = 0; i_ < 32; ++i_) { const int t = 32 * (HF) + i_; const float val = siluf(c0_ * x_[i_] + c1_ * x_[i_ + 1] + c2_ * x_[i_ + 2] + c3_ * x_[i_ + 3]); OUT; } \
        asm volatile("" ::: "memory"); }
#define GDN_CONV_PASS(COLOFF, OUT) do { const float c0_ = cw[(COLOFF)], c1_ = cw[768 + (COLOFF)], c2_ = cw[2 * 768 + (COLOFF)], c3_ = cw[3 * 768 + (COLOFF)]; \
    GDN_CONV_HALF(COLOFF, OUT, 0) GDN_CONV_HALF(COLOFF, OUT, 1) } while (0)
__device__ __forceinline__ void gdn_a_warm(Frame& F, int item) {
    const int c = item & 127, bh = item >> 7, h = bh & 3, b = bh >> 2, lane = F.lane; const size_t r0 = (size_t)b * SEQ + (size_t)c * 64;
    const bf16* wb = (const bf16*)(F.ws + WS_PROJ) + (r0 - (c ? 3 : 0)) * PROJW + PC_DQ + h * 64; const int nr = c ? 67 : 64;
    warm_block(F, wb + 256, PROJW * 2, nr, lane); warm_block(F, wb, PROJW * 2, nr, lane); warm_block(F, wb + 512, PROJW * 2, nr, lane); warm_block(F, (const float*)(F.ws + WS_SMALL) + r0 * 32, 128, 64, lane);
}
__device__ __forceinline__ void gdn_a_item(Frame& F, const Args& a, int l, int item) {
    const int c = item & 127, bh = item >> 7, h = bh & 3, b = bh >> 2; int lane_ = F.lane; asm volatile("" : "+v"(lane_)); const int lane = lane_, r = lane & 31, hh = lane >> 5;
    const size_t r0 = (size_t)b * SEQ + (size_t)c * 64;
    const bf16* PRq = (const bf16*)(F.ws + WS_PROJ) + r0 * PROJW + PC_DQ + h * 64 + lane;
    const float* SM = (const float*)(F.ws + WS_SMALL) + r0 * 32;
    LAS float* Lm = (LAS float*)(F.lds + F.wave * 16384);
    LAS bf16* KT = (LAS bf16*)(F.lds + F.wave * 16384);
    LAS float* tabg = (LAS float*)(F.lds + GDN_TAB_OFF + F.wave * 512); LAS float* tabrb = tabg + 64;
    const float* cw = a.in[10] + (size_t)l * 4 * 768 + h * 64 + lane;
    const float Aexp = __expf(a.in[11][l * 4 + h]), dtb = a.in[12][l * 4 + h];
    float beta_l, gam_l;
    { const float braw = SM[lane * 32 + 16 + h], araw = SM[lane * 32 + 20 + h] + dtb;
      beta_l = 1.f / (1.f + __expf(-braw)); const float sp = araw > 20.f ? araw : log1pf(__expf(araw)); gam_l = wave_incl_scan(-Aexp * sp, lane); }
    const float gam_last = rl(gam_l, 63);
    { float* GB = (float*)(F.ws + WS_GDN_GB) + (r0 + lane) * 8; GB[h] = gam_l; GB[4 + h] = beta_l; }
    const bool first = (c == 0);
    { GBF* QC = (GBF*)(F.ws + WS_GDN_QC) + r0 * 256 + h * 64 + lane;
      GDN_CONV_PASS(0, (void)t; *QC = (bf16)f2bf(val); QC = opq_ptr(QC + 256)); }
    float w[64];
    GDN_LSYNC();
    GDN_CONV_PASS(256, w[t] = val);
    GDN_LSYNC();
#pragma unroll
    for (int t = 0; t < 64; ++t) KT[t * 72 + lane] = (bf16)f2bf(w[t]);
    LDS_WAIT(); asm volatile("" ::: "memory");
    float rn_l;
    { float ss = 0.f;
#pragma unroll
      for (int q = 0; q < 8; ++q) { const v4u u4 = *(const LAS v4u*)(KT + lane * 72 + 8 * q);
#pragma unroll
          for (int e = 0; e < 4; ++e) { const float lo = bflo(u4[e]), hi = bfhi(u4[e]); ss = fmaf(lo, lo, ss); ss = fmaf(hi, hi, ss); } }
      rn_l = rsqrtf(ss + RMS_EPS); }
    tabg[lane] = gam_l; tabrb[lane] = rn_l * beta_l;
    f32x16 lb[3];
    {   bf16x8 fk[2][4];
#pragma unroll
        for (int blk = 0; blk < 2; ++blk)
#pragma unroll
            for (int ks = 0; ks < 4; ++ks) fk[blk][ks] = *(const LAS bf16x8*)(KT + (r + 32 * blk) * 72 + 8 * hh + 16 * ks);
        LDS_WAIT(); asm volatile("" ::: "memory");
#pragma unroll
        for (int bi = 0; bi < 3; ++bi) { const int mb = (bi + 1) >> 1, nb = bi >> 1;
            f32x16 kk;
#pragma unroll
            for (int q = 0; q < 16; ++q) kk[q] = 0.f;
#pragma unroll
            for (int ks = 0; ks < 4; ++ks) kk = mfma32(fk[mb][ks], fk[nb][ks], kk);
            const float cj_rn = bperm(rn_l, r + 32 * nb), cj_g = bperm(gam_l, r + 32 * nb); const int j = r + 32 * nb;
#pragma unroll
            for (int q = 0; q < 16; ++q) { const int i = crow(q, hh) + 32 * mb; const float rb_i = tabrb[i], g_i = tabg[i];
                lb[bi][q] = (j < i) ? kk[q] * rb_i * cj_rn * __expf(g_i - cj_g) : 0.f; } }
    }
    asm volatile("" ::: "memory");
#pragma unroll
    for (int bi = 0; bi < 3; ++bi) { const int mb = (bi + 1) >> 1, nb = bi >> 1;
#pragma unroll
        for (int q = 0; q < 16; ++q) Lm[(crow(q, hh) + 32 * mb) * 64 + r + 32 * nb] = lb[bi][q]; }
    GDN_LSYNC();
    { unsigned k3pk[32]; GBF* KN = (GBF*)(F.ws + WS_GDN_KN) + r0 * 256 + h * 64 + lane;
#pragma unroll
      for (int t2 = 0; t2 < 32; ++t2) { float k3[2];
#pragma unroll
          for (int u = 0; u < 2; ++u) { const int t = 2 * t2 + u; const float rn_t = rl(rn_l, t), g_t = rl(gam_l, t), b_t = rl(beta_l, t);
              const float kn = w[t] * rn_t; *KN = (bf16)f2bf(kn); KN = opq_ptr(KN + 256); k3[u] = kn * __expf(gam_last - g_t); w[t] = kn * b_t * __expf(g_t); }
          k3pk[t2] = pk2(k3[0], k3[1]); }
      v4u* stash = opq_ptr((v4u*)(F.ws + WS_GDN_N + (size_t)gdn_slot(item) * 8192) + lane);
#pragma unroll
      for (int q = 0; q < 8; ++q) { v4u o = {k3pk[4 * q], k3pk[4 * q + 1], k3pk[4 * q + 2], k3pk[4 * q + 3]}; stash[64 * q] = o; } }
    LDS_WAIT(); asm volatile("" ::: "memory");
#define GDN_SOLVE(X) gdn_solve64(X, Lm)
    GDN_LSYNC();
    GDN_SOLVE(w);
    GDN_LSYNC();
    unsigned wpk[32];
#pragma unroll
    for (int t2 = 0; t2 < 32; ++t2) wpk[t2] = pk2(w[2 * t2], w[2 * t2 + 1]);
    { GBF* W = (GBF*)(F.ws + WS_GDN_W) + r0 * 256 + h * 64 + lane;
#pragma unroll
      for (int t = 0; t < 64; ++t) { *W = (bf16)((t & 1) ? (wpk[t >> 1] >> 16) : (wpk[t >> 1] & 0xffffu)); W = opq_ptr(W + 256); } }
#define GDN_K3_RELOAD() unsigned k3pk[32]; { asm volatile("s_waitcnt vmcnt(0)" ::: "memory"); const v4u* stash = opq_ptr((const v4u*)(F.ws + WS_GDN_N + (size_t)gdn_slot(item) * 8192) + lane); \
        _Pragma("unroll") for (int q = 0; q < 8; ++q) { const v4u o = stash[64 * q]; k3pk[4 * q] = o.x; k3pk[4 * q + 1] = o.y; k3pk[4 * q + 2] = o.z; k3pk[4 * q + 3] = o.w; } }
    {   GDN_K3_RELOAD();
        const float egl = __expf(gam_last);
        unsigned char* Mb = opq_ptr(F.ws + WS_GDN_M + (size_t)gdn_slot(item) * 8192 + lane * 16);
#pragma unroll
        for (int mbT = 0; mbT < 2; ++mbT) {
            f32x16 mt[2];
#pragma unroll
            for (int j = 0; j < 2; ++j)
#pragma unroll
                for (int q = 0; q < 16; ++q) mt[j][q] = 0.f;
#pragma unroll
            for (int ks = 0; ks < 4; ++ks) { bf16x8 k3f[2], wf[2]; tok_frags(k3pk, ks, k3f[0], k3f[1]); tok_frags(wpk, ks, wf[0], wf[1]);
#pragma unroll
                for (int y = 0; y < 2; ++y) mt[y] = mfma32(wf[mbT], k3f[y], mt[y]); }
#pragma unroll
            for (int nbT = 0; nbT < 2; ++nbT)
#pragma unroll
                for (int g = 0; g < 4; ++g) { float m4[4];
#pragma unroll
                    for (int k = 0; k < 4; ++k) { const int q = 4 * g + k; m4[k] = -mt[nbT][q] + ((mbT == nbT && crow(q, hh) == r) ? egl : 0.f); }
                    v2u o; o.x = pk2(m4[0], m4[1]); o.y = pk2(m4[2], m4[3]);
                    *(v2u*)(Mb + (((nbT * 2 + mbT) * 2 + (g >> 1)) * 1024 + (g & 1) * 8)) = o; }
            asm volatile("" ::: "memory");
        }
    }
    asm volatile("" ::: "memory");
    unsigned upk[32];
    {   float u[64];
        GDN_LSYNC();
        GDN_CONV_PASS(512, u[t] = val * rl(beta_l, t));
        GDN_LSYNC();
        GDN_SOLVE(u);
        GDN_LSYNC();
#pragma unroll
        for (int t2 = 0; t2 < 32; ++t2) upk[t2] = pk2(u[2 * t2], u[2 * t2 + 1]);
    }
#undef GDN_SOLVE
    { bf16* UT = opq_ptr((bf16*)(F.ws + WS_GDN_UT) + (size_t)item * 4096 + lane * 64);
#pragma unroll
      for (int q = 0; q < 8; ++q) { v4u o = {upk[4 * q], upk[4 * q + 1], upk[4 * q + 2], upk[4 * q + 3]}; *(v4u*)(UT + 8 * q) = o; } }
    {   GDN_K3_RELOAD();
        bf16* Nbase = opq_ptr((bf16*)(F.ws + WS_GDN_N) + (size_t)gdn_slot(item) * 4096 + lane * 4);
        bf16x8 k3fa[4][2];
#pragma unroll
        for (int ks = 0; ks < 4; ++ks) tok_frags(k3pk, ks, k3fa[ks][0], k3fa[ks][1]);
        asm volatile("s_waitcnt vmcnt(0)" ::: "memory");
#pragma unroll
        for (int nb = 0; nb < 2; ++nb) {
            f32x16 nn[2];
#pragma unroll
            for (int j = 0; j < 2; ++j)
#pragma unroll
                for (int q = 0; q < 16; ++q) nn[j][q] = 0.f;
#pragma unroll
            for (int ks = 0; ks < 4; ++ks) { bf16x8 uf[2]; tok_frags(upk, ks, uf[0], uf[1]);
#pragma unroll
                for (int x = 0; x < 2; ++x) nn[x] = mfma32(k3fa[ks][x], uf[nb], nn[x]); }
#pragma unroll
            for (int mb = 0; mb < 2; ++mb)
#pragma unroll
                for (int g = 0; g < 4; ++g) { v2u w2; w2.x = pk2(nn[mb][4 * g], nn[mb][4 * g + 1]); w2.y = pk2(nn[mb][4 * g + 2], nn[mb][4 * g + 3]);
                    *(v2u*)(Nbase + ((nb * 2 + mb) * 4 + g) * 256) = w2; }
            asm volatile("" ::: "memory");
        }
    }
}
#define GAS __attribute__((address_space(1)))
__device__ __forceinline__ void gdn_scan_wave(Frame& F, int bh, int nb) {
    const int lane = F.lane;
    const unsigned char* Mg = F.ws + WS_GDN_M + (size_t)bh * 128 * 8192 + lane * 16;
    unsigned char* Ng = F.ws + WS_GDN_N + (size_t)bh * 128 * 8192 + nb * 4096;
    LAS unsigned char* ring = F.lds;
    constexpr int SLOT = 12288;
#define GDN_SCAN_ISSUE(cc) do { const int c_ = (cc) < 128 ? (cc) : 127; const int so_ = ((cc) & 7) * SLOT; \
        _Pragma("unroll") for (int f = 0; f < 8; ++f) __builtin_amdgcn_global_load_lds((const unsigned*)(Mg + (size_t)c_ * 8192 + f * 1024), (LAS unsigned*)(ring + so_ + f * 1024), 16, 0, 0); \
        _Pragma("unroll") for (int i = 0; i < 4; ++i) __builtin_amdgcn_global_load_lds((const unsigned*)(Ng + (size_t)c_ * 8192 + i * 1024 + lane * 16), (LAS unsigned*)(ring + so_ + 8192 + i * 1024), 16, 0, 0); } while (0)
    f32x16 acc[2];
#pragma unroll
    for (int i = 0; i < 2; ++i)
#pragma unroll
        for (int q = 0; q < 16; ++q) acc[i][q] = 0.f;
    GDN_SCAN_ISSUE(0); GDN_SCAN_ISSUE(1); GDN_SCAN_ISSUE(2); GDN_SCAN_ISSUE(3); GDN_SCAN_ISSUE(4); GDN_SCAN_ISSUE(5);
    for (int c = 0; c < 128; ++c) {
        const int so = (c & 7) * SLOT;
        asm volatile("s_waitcnt vmcnt(60)" ::: "memory");
        bf16x8 mf[2][2][2]; v2u nr[2][4];
#pragma unroll
        for (int mb = 0; mb < 2; ++mb) {
#pragma unroll
            for (int kb = 0; kb < 2; ++kb)
#pragma unroll
                for (int s = 0; s < 2; ++s) mf[mb][kb][s] = *(const LAS bf16x8*)(ring + so + ((mb * 2 + kb) * 2 + s) * 1024 + lane * 16);
#pragma unroll
            for (int g = 0; g < 4; ++g) nr[mb][g] = *(const LAS v2u*)(ring + so + 8192 + (mb * 4 + g) * 512 + lane * 8); }
        asm volatile("s_waitcnt lgkmcnt(0)" ::: "memory");
        __builtin_amdgcn_sched_barrier(0);
        GDN_SCAN_ISSUE(c + 6);
        bf16x8 sfr[2][2];
#pragma unroll
        for (int kb = 0; kb < 2; ++kb)
#pragma unroll
            for (int s = 0; s < 2; ++s) sfr[kb][s] = acc_frag(acc[kb], s);
#pragma unroll
        for (int mb = 0; mb < 2; ++mb)
#pragma unroll
            for (int g = 0; g < 4; ++g) { v2u o; o.x = pk2(acc[mb][4 * g], acc[mb][4 * g + 1]); o.y = pk2(acc[mb][4 * g + 2], acc[mb][4 * g + 3]);
                *(GAS v2u*)(Ng + (size_t)c * 8192 + (mb * 4 + g) * 512 + lane * 8) = o; }
#pragma unroll
        for (int mb = 0; mb < 2; ++mb) { f32x16 t;
#pragma unroll
            for (int g = 0; g < 4; ++g) { t[4 * g] = bflo(nr[mb][g].x); t[4 * g + 1] = bfhi(nr[mb][g].x); t[4 * g + 2] = bflo(nr[mb][g].y); t[4 * g + 3] = bfhi(nr[mb][g].y); }
#pragma unroll
            for (int kb = 0; kb < 2; ++kb)
#pragma unroll
                for (int s = 0; s < 2; ++s) t = mfma32(mf[mb][kb][s], sfr[kb][s], t);
            acc[mb] = t; }
    }
    asm volatile("s_waitcnt vmcnt(0)" ::: "memory");
#undef GDN_SCAN_ISSUE
}
__device__ __forceinline__ void gdn_c_item(Frame& F, const Args& a, int l, int item) {
    const int c = item & 127, bh = item >> 7, h = bh & 3, b = bh >> 2; int lane_ = F.lane; asm volatile("" : "+v"(lane_)); const int lane = lane_, r = lane & 31, hh = lane >> 5;
    const size_t r0 = (size_t)b * SEQ + (size_t)c * 64;
    const bf16* QC = (const bf16*)(F.ws + WS_GDN_QC) + r0 * 256 + h * 64; const bf16* KN = (const bf16*)(F.ws + WS_GDN_KN) + r0 * 256 + h * 64; const bf16* W = (const bf16*)(F.ws + WS_GDN_W) + r0 * 256 + h * 64;
    const bf16* UT = (const bf16*)(F.ws + WS_GDN_UT) + (size_t)item * 4096; const bf16* Sb = (const bf16*)(F.ws + WS_GDN_N) + (size_t)gdn_slot(item) * 4096;
    const float* GB = (const float*)(F.ws + WS_GDN_GB) + r0 * 8;
    const float gam_l = GB[lane * 8 + h];
    float gi[2], rnq[2];
    bf16x8 qf[2][2][2];
#pragma unroll
    for (int ib = 0; ib < 2; ++ib) { gi[ib] = GB[(r + 32 * ib) * 8 + h]; float ss = 0.f;
#pragma unroll
        for (int mb = 0; mb < 2; ++mb)
#pragma unroll
            for (int s = 0; s < 2; ++s) { qf[ib][mb][s] = load_row_frag(QC + (size_t)(r + 32 * ib) * 256 + 32 * mb + 16 * s + 4 * hh);
                const v4u qq = __builtin_bit_cast(v4u, qf[ib][mb][s]);
#pragma unroll
                for (int e = 0; e < 4; ++e) { const float lo = bflo(qq[e]), hi = bfhi(qq[e]); ss = fmaf(lo, lo, ss); ss = fmaf(hi, hi, ss); } }
        ss += bperm(ss, lane ^ 32); rnq[ib] = rsqrtf(ss + RMS_EPS) * 0.125f; }
    f32x16 pt[2][2], ot[2][2];
#pragma unroll
    for (int i = 0; i < 2; ++i)
#pragma unroll
        for (int j = 0; j < 2; ++j)
#pragma unroll
            for (int q = 0; q < 16; ++q) { pt[i][j][q] = 0.f; ot[i][j][q] = 0.f; }
#pragma unroll
    for (int jb = 0; jb < 2; ++jb)
#pragma unroll
        for (int mb = 0; mb < 2; ++mb)
#pragma unroll
            for (int s = 0; s < 2; ++s) { const bf16x8 kf = load_row_frag(KN + (size_t)(r + 32 * jb) * 256 + 32 * mb + 16 * s + 4 * hh);
#pragma unroll
                for (int ib = jb; ib < 2; ++ib) pt[jb][ib] = mfma32(kf, qf[ib][mb][s], pt[jb][ib]); }
#pragma unroll
    for (int jb = 0; jb < 2; ++jb)
#pragma unroll
        for (int q = 0; q < 16; ++q) { const int jl = crow(q, hh); const float gj = bperm(gam_l, jl + 32 * jb);
#pragma unroll
            for (int ib = jb; ib < 2; ++ib) { const bool keep = (ib > jb) || (jl <= r); pt[jb][ib][q] = keep ? pt[jb][ib][q] * rnq[ib] * __expf(gi[ib] - gj) : 0.f; } }
    {   bf16x8 sf[2][2][2];
#pragma unroll
        for (int eb = 0; eb < 2; ++eb)
#pragma unroll
            for (int mb = 0; mb < 2; ++mb)
#pragma unroll
                for (int s = 0; s < 2; ++s) sf[eb][mb][s] = load_acc_frag(Sb, eb, mb, s, lane);
#pragma unroll
        for (int eb = 0; eb < 2; ++eb)
#pragma unroll
            for (int mb = 0; mb < 2; ++mb)
#pragma unroll
                for (int s = 0; s < 2; ++s)
#pragma unroll
                    for (int ib = 0; ib < 2; ++ib) ot[eb][ib] = mfma32(sf[eb][mb][s], qf[ib][mb][s], ot[eb][ib]);
#pragma unroll
        for (int ib = 0; ib < 2; ++ib) { const float sc = rnq[ib] * __expf(gi[ib]);
#pragma unroll
            for (int eb = 0; eb < 2; ++eb)
#pragma unroll
                for (int q = 0; q < 16; ++q) ot[eb][ib][q] *= sc; }
#pragma unroll
        for (int jb = 0; jb < 2; ++jb) {
            f32x16 vn[2];
#pragma unroll
            for (int eb = 0; eb < 2; ++eb)
#pragma unroll
                for (int q = 0; q < 16; ++q) vn[eb][q] = 0.f;
#pragma unroll
            for (int mb = 0; mb < 2; ++mb)
#pragma unroll
                for (int s = 0; s < 2; ++s) { const bf16x8 wf = load_row_frag(W + (size_t)(r + 32 * jb) * 256 + 32 * mb + 16 * s + 4 * hh);
#pragma unroll
                    for (int eb = 0; eb < 2; ++eb) vn[eb] = mfma32(wf, sf[eb][mb][s], vn[eb]); }
#pragma unroll
            for (int eb = 0; eb < 2; ++eb)
#pragma unroll
                for (int g = 0; g < 4; ++g) { const v2u uu = *(const v2u*)(UT + (size_t)(r + 32 * eb) * 64 + 32 * jb + 8 * g + 4 * hh);
                    vn[eb][4 * g] = bflo(uu.x) - vn[eb][4 * g]; vn[eb][4 * g + 1] = bfhi(uu.x) - vn[eb][4 * g + 1];
                    vn[eb][4 * g + 2] = bflo(uu.y) - vn[eb][4 * g + 2]; vn[eb][4 * g + 3] = bfhi(uu.y) - vn[eb][4 * g + 3]; }
#pragma unroll
            for (int s = 0; s < 2; ++s) { bf16x8 vf[2];
#pragma unroll
                for (int eb = 0; eb < 2; ++eb) vf[eb] = acc_frag(vn[eb], s);
#pragma unroll
                for (int ib = jb; ib < 2; ++ib) { const bf16x8 pf = acc_frag(pt[jb][ib], s);
#pragma unroll
                    for (int eb = 0; eb < 2; ++eb) ot[eb][ib] = mfma32(vf[eb], pf, ot[eb][ib]); } }
        }
    }
    const float* nw = a.in[13] + l * 64; bf16* MIXp = (bf16*)(F.ws + WS_MIX); const bf16* PZ = (const bf16*)(F.ws + WS_PROJ) + r0 * PROJW + PC_DZ + h * 64;
#pragma unroll
    for (int ib = 0; ib < 2; ++ib) { float ss = 0.f;
#pragma unroll
        for (int eb = 0; eb < 2; ++eb)
#pragma unroll
            for (int q = 0; q < 16; ++q) ss = fmaf(ot[eb][ib][q], ot[eb][ib][q], ss);
        ss += bperm(ss, lane ^ 32); const float rs = rsqrtf(ss * (1.f / 64.f) + RMS_EPS);
        const size_t row = r0 + r + 32 * ib;
#pragma unroll
        for (int eb = 0; eb < 2; ++eb) { v2u pkd[4];
#pragma unroll
            for (int g = 0; g < 4; ++g) { const int e0 = 32 * eb + 8 * g + 4 * hh;
                const v2u zz = *(const v2u*)(PZ + (size_t)(r + 32 * ib) * PROJW + e0); const f32x4 w4 = *(const f32x4*)(nw + e0);
                const float y0 = ot[eb][ib][4 * g] * rs * w4.x * siluf(bflo(zz.x)), y1 = ot[eb][ib][4 * g + 1] * rs * w4.y * siluf(bfhi(zz.x));
                const float y2 = ot[eb][ib][4 * g + 2] * rs * w4.z * siluf(bflo(zz.y)), y3 = ot[eb][ib][4 * g + 3] * rs * w4.w * siluf(bfhi(zz.y));
                pkd[g].x = pk2(y0, y1); pkd[g].y = pk2(y2, y3); }
            store_row32_wide(MIXp + row * DM + 256 + h * 64 + 32 * eb, pkd, hh); }
    }
}
constexpr size_t WS_SEL = 500 * MiB;
constexpr size_t WS_PART1 = 468 * MiB;
constexpr size_t WS_LP = 502 * MiB;
constexpr size_t WS_END3 = 506 * MiB;
constexpr float MOBA_C = 0.125f * 1.4426950408889634f;
constexpr int KL_STRIDE = 72, VL_STRIDE = 72;
constexpr int MOBA_KL_OFF = 0, MOBA_VL_OFF = 256 * 72 * 2, MOBA_LIST_OFF = MOBA_VL_OFF + 256 * 72 * 2, MOBA_MISC_OFF = MOBA_LIST_OFF + 8192 * 2;

__device__ __forceinline__ void moba_gate_wg(Frame& F, int item) {
    const int grp = item & 15, bh = item >> 4, h = bh & 7, b = bh >> 3; const int lane = F.lane;
    LAS float* kml = (LAS float*)F.lds;
    { const f32x4* km = (const f32x4*)((const float*)(F.ws + WS_KMEAN) + (size_t)F.layer * 65536 + (size_t)bh * 32 * 64) + F.tid; *(LAS f32x4*)(kml + 4 * F.tid) = *km; }
    const int qb = grp * 8 + F.wave; const int t = qb * 64 + lane, own = (qb * 64) >> 8;
    const bf16* qp = (const bf16*)(F.ws + WS_PROJ) + ((size_t)b * SEQ + t) * PROJW + PC_MQ + h * 64;
    float q[64];
#pragma unroll
    for (int c = 0; c < 8; ++c) { const v4u u = ((const v4u*)qp)[c];
#pragma unroll
        for (int e = 0; e < 4; ++e) { q[8 * c + 2 * e] = bflo(u[e]); q[8 * c + 2 * e + 1] = bfhi(u[e]); } }
    __syncthreads();
    float v0 = -INFINITY, v1 = -INFINITY, v2 = -INFINITY; unsigned i0 = 0xFF, i1 = 0xFF, i2 = 0xFF;
    for (int n = 0; n < own; ++n) {
        float s = 0.f;
#pragma unroll
        for (int c = 0; c < 16; ++c) { const f32x4 k4 = *(const LAS f32x4*)(kml + n * 64 + 4 * c);
            s = fmaf(q[4 * c], k4.x, s); s = fmaf(q[4 * c + 1], k4.y, s); s = fmaf(q[4 * c + 2], k4.z, s); s = fmaf(q[4 * c + 3], k4.w, s); }
        if (s > v0) { v2 = v1; i2 = i1; v1 = v0; i1 = i0; v0 = s; i0 = n; }
        else if (s > v1) { v2 = v1; i2 = i1; v1 = s; i1 = n; }
        else if (s > v2) { v2 = s; i2 = n; }
    }
    ((unsigned*)(F.ws + WS_SEL))[(size_t)bh * SEQ + t] = i0 | (i1 << 8) | (i2 << 16);
    __syncthreads();
}
typedef short s16x4 __attribute__((ext_vector_type(4)));
__device__ __forceinline__ s16x4 moba_vtr(const LAS bf16* p) { return __builtin_bit_cast(s16x4, __builtin_amdgcn_ds_read_tr16_b64_v4i16((LAS s16x4*)p)); }
template <bool CAUSAL, int NKB, int NIB>
__device__ __forceinline__ void moba_tile(const LAS bf16* KL, const LAS bf16* VL, const bf16* q0p, const bf16* q1p, float kmaxc, int nkb, int pos0, int pos1, int lane, f32x16 (&ot)[2][2], float (&lsum)[2]) {
    const int r = lane & 31, hh = lane >> 5;
    bf16x8 qf[2][4]; float mref[2];
#pragma unroll
    for (int ib = 0; ib < NIB; ++ib) { const bf16* qp = ib ? q1p : q0p; float ss = 0.f;
#pragma unroll
        for (int ks = 0; ks < 4; ++ks) { const v4u u = *(const v4u*)(qp + 8 * hh + 16 * ks); qf[ib][ks] = __builtin_bit_cast(bf16x8, u);
#pragma unroll
            for (int e = 0; e < 4; ++e) { const float lo = bflo(u[e]), hi = bfhi(u[e]); ss = fmaf(lo, lo, ss); ss = fmaf(hi, hi, ss); } }
        ss += bperm(ss, lane ^ 32); mref[ib] = sqrtf(ss) * kmaxc; lsum[ib] = 0.f; }
#pragma unroll
    for (int i = 0; i < 2; ++i)
#pragma unroll
        for (int j = 0; j < 2; ++j)
#pragma unroll
            for (int q = 0; q < 16; ++q) ot[i][j][q] = 0.f;
#define MOBA_KB_BODY(jb) {         f32x16 st[2]; \
_Pragma("unroll") \
        for (int ib = 0; ib < NIB; ++ib) \
_Pragma("unroll") \
            for (int q = 0; q < 16; ++q) st[ib][q] = 0.f; \
_Pragma("unroll") \
        for (int ks = 0; ks < 4; ++ks) { const bf16x8 kf = *(const LAS bf16x8*)(KL + (32 * jb + r) * KL_STRIDE + 8 * hh + 16 * ks); \
            st[0] = mfma32(kf, qf[0][ks], st[0]); if (NIB > 1) st[1] = mfma32(kf, qf[1][ks], st[1]); } \
_Pragma("unroll") \
        for (int ib = 0; ib < NIB; ++ib) { const int pos = ib ? pos1 : pos0; float ls = 0.f; \
_Pragma("unroll") \
            for (int q = 0; q < 16; ++q) { float p = __builtin_amdgcn_exp2f(fmaf(st[ib][q], MOBA_C, -mref[ib])); \
                if (CAUSAL) { if (32 * jb + crow(q, hh) > pos) p = 0.f; } \
                st[ib][q] = p; ls += p; } \
            lsum[ib] += ls; } \
_Pragma("unroll") \
        for (int s = 0; s < 2; ++s) { const bf16x8 pf0 = acc_frag(st[0], s), pf1 = acc_frag(st[NIB - 1], s); \
_Pragma("unroll") \
            for (int eb = 0; eb < 2; ++eb) { const LAS bf16* vp = VL + (32 * jb + 16 * s + 4 * hh + ((lane >> 2) & 3)) * VL_STRIDE + 32 * eb + 16 * ((lane >> 4) & 1) + 4 * (lane & 3); \
                const s16x4 lo = moba_vtr(vp), hi = moba_vtr(vp + 8 * VL_STRIDE); const bf16x8 vf = (bf16x8){lo[0], lo[1], lo[2], lo[3], hi[0], hi[1], hi[2], hi[3]}; \
                ot[eb][0] = mfma32(vf, pf0, ot[eb][0]); if (NIB > 1) ot[eb][1] = mfma32(vf, pf1, ot[eb][1]); } } \
     }
    if constexpr (NKB > 0) {
#pragma unroll
        for (int jb = 0; jb < NKB; ++jb) MOBA_KB_BODY(jb)
    } else {
#pragma nounroll
        for (int jb = 0; jb < nkb; ++jb) MOBA_KB_BODY(jb)
    }
#undef MOBA_KB_BODY
#pragma unroll
    for (int ib = 0; ib < NIB; ++ib) lsum[ib] += bperm(lsum[ib], lane ^ 32);
}
__device__ __forceinline__ void moba_load_kv(Frame& F, int b, int h, int n) {
    const bf16* PROJ = (const bf16*)(F.ws + WS_PROJ);
    LAS bf16* KL = (LAS bf16*)(F.lds + MOBA_KL_OFF); LAS bf16* VL = (LAS bf16*)(F.lds + MOBA_VL_OFF);
#pragma unroll
    for (int c = 0; c < 4; ++c) { const int ch = F.tid + 512 * c; const int row = ch >> 3, part = ch & 7;
        const v4u u = *(const v4u*)(PROJ + ((size_t)b * SEQ + n * 256 + row) * PROJW + PC_MK + h * 64 + part * 8); *(LAS v4u*)(KL + row * KL_STRIDE + part * 8) = u; }
#pragma unroll
    for (int c = 0; c < 4; ++c) { const int ch = F.tid + 512 * c; const int row = ch >> 3, part = ch & 7;
        const v4u u = *(const v4u*)(PROJ + ((size_t)b * SEQ + n * 256 + row) * PROJW + PC_MV + h * 64 + part * 8); *(LAS v4u*)(VL + row * VL_STRIDE + part * 8) = u; }
}
__device__ __forceinline__ float moba_kmaxc(Frame& F, int b, int h) {
    const unsigned* km = (const unsigned*)(F.ws + WS_KMAXH) + F.layer * 64 + (b * 8 + h) * 2; return sqrtf(__uint_as_float(km[0]) + __uint_as_float(km[1])) * MOBA_C;
}
__device__ __forceinline__ bf16* moba_part_ptr(Frame& F, int slot, size_t row, int h) {
    const size_t o0 = WS_MIX + (row * DM + 512 + h * 64) * 2, o1 = WS_PART1 + (row * 8 + h) * 128, o2 = WS_PROJ + (row * PROJW + PC_DQ + h * 64) * 2;
    return (bf16*)(F.ws + (slot == 0 ? o0 : slot == 1 ? o1 : o2)); }
__device__ __forceinline__ void moba_pd_item(Frame& F, int b, int h, int n) {
    LAS bf16* KL = (LAS bf16*)(F.lds + MOBA_KL_OFF); LAS bf16* VL = (LAS bf16*)(F.lds + MOBA_VL_OFF);
    LAS unsigned short* list = (LAS unsigned short*)(F.lds + MOBA_LIST_OFF); LAS unsigned* misc = (LAS unsigned*)(F.lds + MOBA_MISC_OFF);
    const int lane = F.lane, r = lane & 31, hh = lane >> 5;
    moba_load_kv(F, b, h, n);
    const unsigned* SEL = (const unsigned*)(F.ws + WS_SEL) + (size_t)(b * 8 + h) * SEQ;
    const int tq0 = (n + 1) * 256, per = (SEQ - tq0) >> 3;
    const int ws0 = tq0 + F.wave * per;
    unsigned sv[16];
#pragma unroll
    for (int i = 0; i < 16; ++i) { const int t = ws0 + 64 * i + lane; sv[i] = (64 * i + lane < per) ? SEL[t] : 0xFFFFFFFFu; }
    int slotv[16]; int cnt = 0;
#pragma unroll
    for (int i = 0; i < 16; ++i) { const unsigned s = sv[i];
        slotv[i] = ((s & 0xFF) == (unsigned)n) ? 0 : (((s >> 8) & 0xFF) == (unsigned)n) ? 1 : (((s >> 16) & 0xFF) == (unsigned)n) ? 2 : -1;
        cnt += __popcll(__ballot(slotv[i] >= 0)); }
    if (lane == 0) misc[F.wave] = (unsigned)cnt;
    __syncthreads();
    int off = 0, total = 0;
#pragma unroll
    for (int w = 0; w < 8; ++w) { const int c = (int)misc[w]; if (w < F.wave) off += c; total += c; }
#pragma unroll
    for (int i = 0; i < 16; ++i) { const unsigned long long bal = __ballot(slotv[i] >= 0); const int pre = __popcll(bal & ((1ull << lane) - 1ull));
        if (slotv[i] >= 0) list[off + pre] = (unsigned short)((ws0 + 64 * i + lane) | (slotv[i] << 13));
        off += __popcll(bal); }
    const float kmaxc = moba_kmaxc(F, b, h);
    __syncthreads();
    const bf16* PROJ = (const bf16*)(F.ws + WS_PROJ); float* LP = (float*)(F.ws + WS_LP);
    for (int tile = F.wave; tile * 64 < total; tile += 8) {
        int idx[2], tq[2], slot[2]; size_t row[2];
#pragma unroll
        for (int ib = 0; ib < 2; ++ib) { idx[ib] = tile * 64 + 32 * ib + r; const int ii = idx[ib] < total ? idx[ib] : total - 1; const unsigned e = list[ii]; tq[ib] = e & 0x1fff; slot[ib] = e >> 13; row[ib] = (size_t)b * SEQ + tq[ib]; }
        f32x16 ot[2][2]; float lsum[2];
        moba_tile<false, 8, 2>(KL, VL, PROJ + row[0] * PROJW + PC_MQ + h * 64, PROJ + row[1] * PROJW + PC_MQ + h * 64, kmaxc, 8, 0, 0, lane, ot, lsum);
#pragma unroll
        for (int ib = 0; ib < 2; ++ib) if (idx[ib] < total) {
            bf16* pp = moba_part_ptr(F, slot[ib], row[ib], h) + 32 * hh;
#pragma unroll
            for (int j = 0; j < 4; ++j) { const int eb = j >> 1, g = 2 * (j & 1); v4u w;
                w.x = pk2(ot[eb][ib][4 * g], ot[eb][ib][4 * g + 1]); w.y = pk2(ot[eb][ib][4 * g + 2], ot[eb][ib][4 * g + 3]);
                w.z = pk2(ot[eb][ib][4 * g + 4], ot[eb][ib][4 * g + 5]); w.w = pk2(ot[eb][ib][4 * g + 6], ot[eb][ib][4 * g + 7]); ((v4u*)pp)[j] = w; }
            if (hh == 0) LP[(row[ib] * 8 + h) * 4 + slot[ib]] = lsum[ib]; }
    }
    __syncthreads();
}
__device__ __forceinline__ void moba_pe_item(Frame& F, int b, int h, int o) {
    LAS bf16* KL = (LAS bf16*)(F.lds + MOBA_KL_OFF); LAS bf16* VL = (LAS bf16*)(F.lds + MOBA_VL_OFF);
    const int lane = F.lane, r = lane & 31, hh = lane >> 5;
    moba_load_kv(F, b, h, o);
    const float kmaxc = moba_kmaxc(F, b, h);
    __syncthreads();
    {
        const int t = F.wave; const bf16* PROJ = (const bf16*)(F.ws + WS_PROJ); const float* LP = (const float*)(F.ws + WS_LP); bf16* MIXp = (bf16*)(F.ws + WS_MIX);
        const int pos = 32 * t + r; const size_t row = (size_t)b * SEQ + o * 256 + pos;
        f32x16 ot[2][2]; float lsum[2];
        moba_tile<true, 0, 1>(KL, VL, PROJ + row * PROJW + PC_MQ + h * 64, PROJ + row * PROJW + PC_MQ + h * 64, kmaxc, t + 1, pos, pos, lane, ot, lsum);
        const int nsel = o < 3 ? o : 3;
        float l = lsum[0];
        for (int s = 0; s < nsel; ++s) { l += LP[(row * 8 + h) * 4 + s]; const bf16* pp = moba_part_ptr(F, s, row, h) + 32 * hh;
#pragma unroll
            for (int j = 0; j < 4; ++j) { const int eb = j >> 1, g = 2 * (j & 1); const v4u w = ((const v4u*)pp)[j];
                ot[eb][0][4 * g] += bflo(w.x); ot[eb][0][4 * g + 1] += bfhi(w.x); ot[eb][0][4 * g + 2] += bflo(w.y); ot[eb][0][4 * g + 3] += bfhi(w.y);
                ot[eb][0][4 * g + 4] += bflo(w.z); ot[eb][0][4 * g + 5] += bfhi(w.z); ot[eb][0][4 * g + 6] += bflo(w.w); ot[eb][0][4 * g + 7] += bfhi(w.w); } }
        const float il = 1.f / l;
#pragma unroll
        for (int eb = 0; eb < 2; ++eb) { v2u pkd[4];
#pragma unroll
            for (int g = 0; g < 4; ++g) { pkd[g].x = pk2(ot[eb][0][4 * g] * il, ot[eb][0][4 * g + 1] * il); pkd[g].y = pk2(ot[eb][0][4 * g + 2] * il, ot[eb][0][4 * g + 3] * il); }
            store_row32_wide(MIXp + row * DM + 512 + h * 64 + 32 * eb, pkd, hh); }
    }
    __syncthreads();
}
__global__ void __launch_bounds__(NTHREADS, 2) mk_fwd(Args args) {
    extern __shared__ __attribute__((aligned(16))) unsigned char lds[];
    cg::grid_group grid = cg::this_grid();
    Frame F; F.lds = (LAS unsigned char*)lds; F.ldsg = lds; F.tid = threadIdx.x; F.lane = F.tid & 63; F.wave = __builtin_amdgcn_readfirstlane(F.tid >> 6);
    F.G = gridDim.x; F.wave_s = __builtin_amdgcn_readfirstlane((int)(threadIdx.x >> 6)); refresh(F, args);
#define XB ((bf16*)(F.ws + WS_XB))
#define PROJ ((bf16*)(F.ws + WS_PROJ))
#define MIX ((bf16*)(F.ws + WS_MIX))
#define RSTD ((float*)(F.ws + WS_RSTD))
#define SMALL ((float*)(F.ws + WS_SMALL))
#define GRID_BAR() do { xcd_barrier(bar); refresh(F, args); } while (0)
    volatile LAS unsigned* MISC = (volatile LAS unsigned*)(F.lds + LDS_BYTES - 64);
    if (F.tid < 16) MISC[F.tid] = 0u;
    __syncthreads();
    XcdBarrier bar = xcd_barrier_post((unsigned*)(F.ws + WS_CTL) + 4096, MISC + 8);
    p0_weights(F, args, 0, 0, F.wave * F.G + F.bid, F.G * NWAVES, 0, W_ITEMS_EARLY);     p0_table(F); p0_xb(F, args.in[0], (bf16*)args.out);
    __syncthreads(); grid.sync(); refresh(F, args);

    for (int l_ = 0; l_ < DEPTH; ++l_) {
        int l = l_; asm volatile("" : "+s"(l)); F.layer = l;
#define WL(off) ((const bf16*)(F.ws + WS_W + (size_t)l * W_LAYER + (off)))
#define Win WL(W_IN_OFF)
#define Wo WL(W_O_OFF)
#define Wgu WL(W_GU_OFF)
#define Wd WL(W_D_OFF)
        bf16* const RB = (bf16*)args.out;
        bf16* const RB2 = (l == DEPTH - 1) ? MIX : RB;
        { pg8::Gemm g{RB, Win, MTOK, PROJW, DM}; pg8::StaticOrder S; S.init(MTOK, PROJW, F.G, F.bid); pg8::EpiInProj E{PROJ, SMALL, RSTD, (const float*)(F.ws + WS_TAB), (float*)(F.ws + WS_KMEAN) + (size_t)l * 65536, (unsigned*)(F.ws + WS_KMAXH) + l * 64};
          pg8::gemm_phase<pg8::EpiInProj, pg8::StaticOrder, true, true>(F.lds, g, S, E, F.tid); }
        for (int tile = F.bid * NWAVES + F.wave; tile < MTOK / 16; tile += F.G * NWAVES) small_proj_tile(F, RB, Win, RSTD, tile);
        GRID_BAR();
        for (int it = F.bid * NWAVES + F.wave; it < 2048; it += F.G * NWAVES) { gla_a_warm(F, it); gdn_a_warm(F, it); gla_a_item(F, args, l, it); __builtin_amdgcn_s_barrier(); gdn_a_item(F, args, l, it); }
        __syncthreads();
        for (int it = F.bid; it < 512; it += F.G) moba_gate_wg(F, (it < 256) ? it : 767 - it);
        GRID_BAR();
        if (F.bid < 32) {
            if (F.wave == 0) gdn_scan_wave(F, F.bid >> 1, F.bid & 1);
            else { for (int gi = F.bid * 448 + (F.tid - 64); gi < 16384; gi += 32 * 448) gla_scan(F, gi); } }
        else p0_weights(F, args, 1, l, F.wave * (F.G - 32) + (F.bid - 32), (F.G - 32) * NWAVES, l == 0 ? 0 : W_ITEMS_EARLY, W_ITEMS_ALL);
        __syncthreads();
        { volatile LAS unsigned* qslot = (volatile LAS unsigned*)(F.lds + LDS_BYTES - 64) + 4;
          for (;;) { if (F.tid == 0) qslot[0] = __hip_atomic_fetch_add((unsigned*)(F.ws + WS_CTL) + 24 + l, 1u, __ATOMIC_RELAXED, __HIP_MEMORY_SCOPE_AGENT);
              __syncthreads(); const unsigned q = qslot[0]; __syncthreads();
              if (q >= 992u) break;
              const int n = (int)(q >> 5), bh = (int)(q & 31u); moba_pd_item(F, bh >> 3, bh & 7, n); } }
        GRID_BAR();
        for (int it = F.bid * NWAVES + F.wave; it < 2048; it += F.G * NWAVES) { gla_c_item(F, args, l, it); __builtin_amdgcn_s_barrier(); gdn_c_item(F, args, l, it); }
        __syncthreads();
        for (int it = F.bid; it < 1024; it += F.G) moba_pe_item(F, (it & 31) >> 3, it & 7, it >> 5);
        GRID_BAR();
        { pg8::Gemm g{MIX, Wo, MTOK, DM, DM}; pg8::StaticOrder S; S.init(MTOK, DM, F.G, F.bid); pg8::EpiPlainBf16 E{XB, DM};
          pg8::gemm_phase<pg8::EpiPlainBf16, pg8::StaticOrder, true, true>(F.lds, g, S, E, F.tid); }
        GRID_BAR();
        norm_pass(F, RB, RB2, nullptr, args.in[2] + l * DM, false);
        GRID_BAR();
        { pg8::Gemm g{RB2, Wgu, MTOK, 2 * DFF, DM}; pg8::StaticOrder S; S.init(MTOK, 2 * DFF, F.G, F.bid); pg8::EpiSwiglu E{PROJ, RSTD};
          pg8::gemm_phase<pg8::EpiSwiglu, pg8::StaticOrder, true, true>(F.lds, g, S, E, F.tid); }
        GRID_BAR();
        { pg8::Gemm g{PROJ, Wd, MTOK, DM, DFF}; pg8::StaticOrder S; S.init(MTOK, DM, F.G, F.bid); pg8::EpiPlainBf16 E{XB, DM};
          pg8::gemm_phase<pg8::EpiPlainBf16, pg8::StaticOrder, true, true>(F.lds, g, S, E, F.tid); }
        GRID_BAR();
        norm_pass(F, RB2, RB2, args.out, args.in[4] + l * DM, l == DEPTH - 1);
        if (l_ + 1 < DEPTH) GRID_BAR();
    }
}

extern "C" void kernel_launch(void* const* d_in, const int* in_sizes, int n_in, void* d_out, int out_size, void* d_ws, size_t ws_size, hipStream_t stream) {
    static int grid = 0;
    if (grid == 0) {
        if (n_in != 17 || in_sizes[0] != MTOK * DM || out_size != MTOK * DM || ws_size < WS_END3) { fprintf(stderr, "kernel_launch: unexpected shapes / workspace (n_in %d, ws %zu < %zu)\n", n_in, ws_size, (size_t)WS_END3); grid = -1; return; }
        int dev = 0, cus = 0, per_cu = 0;
        if (hipGetDevice(&dev) != hipSuccess || hipDeviceGetAttribute(&cus, hipDeviceAttributeMultiprocessorCount, dev) != hipSuccess) { grid = -1; return; }
        if (hipFuncSetAttribute((const void*)mk_fwd, hipFuncAttributeMaxDynamicSharedMemorySize, LDS_BYTES) != hipSuccess) { fprintf(stderr, "kernel_launch: hipFuncSetAttribute failed\n"); grid = -1; return; }
        if (hipOccupancyMaxActiveBlocksPerMultiprocessor(&per_cu, (const void*)mk_fwd, NTHREADS, LDS_BYTES) != hipSuccess || per_cu < 1) { fprintf(stderr, "kernel_launch: occupancy query says %d\n", per_cu); (void)hipGetLastError(); grid = -1; return; }
        grid = cus;
    }
    if (grid < 0) return;
    (void)hipMemsetAsync((char*)d_ws + WS_CTL, 0, CTL_ZERO_BYTES, stream);
    Args a{};
    for (int i = 0; i < 17; ++i) a.in[i] = (const float*)d_in[i];
    a.out = (float*)d_out; a.ws = (unsigned char*)d_ws;
    void* kargs[] = {&a};
    hipError_t e = hipLaunchCooperativeKernel((const void*)mk_fwd, dim3(grid), dim3(NTHREADS), kargs, LDS_BYTES, stream);
    if (e != hipSuccess) fprintf(stderr, "kernel_launch: cooperative launch failed: %s (grid %d)\n", hipGetErrorString(e), grid);
}
```
